# Optimizing an MI355X kernel written in HIP

```python
import jax, jax.numpy as jnp
from jax import lax
import numpy as np

D_MODEL = 1024
BATCH = 16
SEQ = 2048
DEPTH = 2

CONV_GROUPS = 8
CONV_GROUP_DIM = 64
CONV_DIM = CONV_GROUPS * CONV_GROUP_DIM
CONV_WIDTH = 3
GLA_HEADS = 4
GLA_DK = 64
GLA_DV = 128
GLA_RANK = 16
GLA_TAU = 16.0
GLA_CHUNK = 64
SWA_HEADS = 8
SWA_KV_HEADS = 2
SWA_HEAD_DIM = 64
SWA_WINDOW = 128
SWA_BLOCK = 128
ROPE_THETA = 500000.0
ROPE_DIM = SWA_HEAD_DIM // 4
N_BRANCHES = 3
BRANCH_WIDTH = 512
D_FF = 4 * D_MODEL
NORM_EPS = 1e-6
SPLITS = (CONV_DIM, CONV_DIM, CONV_DIM,
          GLA_HEADS * GLA_DK, GLA_HEADS * GLA_DK, GLA_HEADS * GLA_DV, GLA_HEADS * GLA_DV, GLA_RANK,
          SWA_HEADS * SWA_HEAD_DIM, SWA_KV_HEADS * SWA_HEAD_DIM, SWA_KV_HEADS * SWA_HEAD_DIM,
          N_BRANCHES * D_MODEL)
N_IN = sum(SPLITS)

kernel_name = "hybrid_conv_gla_swa_parallel_gated"


def rms_norm(x, w):
    x32 = x.astype(jnp.float32)
    y = x32 * lax.rsqrt(jnp.mean(x32 * x32, axis=-1, keepdims=True) + NORM_EPS)
    return (y * w.astype(jnp.float32)).astype(x.dtype)


def short_conv_mixer(cx, cb, cc, conv_w, conv_b):
    u = cc * cx
    y = lax.conv_general_dilated(
        u, conv_w[:, None, :], window_strides=(1,), padding=[(CONV_WIDTH - 1, 0)],
        dimension_numbers=('NWC', 'WIO', 'NWC'), feature_group_count=CONV_DIM)
    return cb * (y + conv_b)


def gla_mixer(q, k, v, r, a, wa2, ba, onorm_w):
    f32 = jnp.float32
    Bsz, S, _ = q.shape
    N, L = S // GLA_CHUNK, GLA_CHUNK

    def heads(t, d):
        return t.reshape(Bsz, N, L, GLA_HEADS, d).transpose(0, 3, 1, 2, 4)

    q = heads(q.astype(f32) * GLA_DK ** -0.5, GLA_DK)
    k = heads(k.astype(f32), GLA_DK)
    v = heads(v.astype(f32), GLA_DV)
    glog = jax.nn.log_sigmoid((a @ wa2 + ba).astype(f32)) / GLA_TAU
    b = jnp.cumsum(heads(glog, GLA_DK), axis=3)
    b_last = b[:, :, :, -1:, :]
    q_in = q * jnp.exp(b)
    k_in = k * jnp.exp(-b)
    k_end = k * jnp.exp(b_last - b)
    causal = jnp.tril(jnp.ones((L, L), dtype=bool))
    att = jnp.where(causal, jnp.einsum('bhnid,bhnjd->bhnij', q_in, k_in), 0.0)
    o_intra = jnp.einsum('bhnij,bhnjv->bhniv', att, v)
    chunk_kv = jnp.einsum('bhnjd,bhnjv->bhndv', k_end, v)
    chunk_decay = jnp.exp(b_last[:, :, :, 0, :])

    def step(state, inp):
        kv_n, dec_n = inp
        return dec_n[..., None] * state + kv_n, state

    init = jnp.zeros((Bsz, GLA_HEADS, GLA_DK, GLA_DV), f32)
    _, states = lax.scan(step, init, (jnp.moveaxis(chunk_kv, 2, 0), jnp.moveaxis(chunk_decay, 2, 0)))
    states = jnp.moveaxis(states, 0, 2)
    o = o_intra + jnp.einsum('bhnid,bhndv->bhniv', q_in, states)
    o = o.transpose(0, 2, 3, 1, 4).reshape(Bsz, S, GLA_HEADS, GLA_DV)
    o = rms_norm(o, onorm_w).reshape(Bsz, S, GLA_HEADS * GLA_DV)
    return (o * jax.nn.silu(r.astype(f32))).astype(r.dtype)


def rope_partial(x, cos, sin):
    half = ROPE_DIM // 2
    x1, x2, rest = x[..., :half], x[..., half:ROPE_DIM], x[..., ROPE_DIM:]
    return jnp.concatenate([x1 * cos - x2 * sin, x2 * cos + x1 * sin, rest], axis=-1)


def with_prev_block(t):
    pad = ((0, 0), (1, 0)) + ((0, 0),) * (t.ndim - 2)
    prev = jnp.pad(t, pad)[:, :-1]
    return jnp.concatenate([prev, t], axis=2)


def swa_mixer(q, k, v, positions, qn_w, kn_w, sinks):
    f32 = jnp.float32
    Bsz, S, _ = q.shape
    G = SWA_HEADS // SWA_KV_HEADS
    N, T = S // SWA_BLOCK, SWA_BLOCK
    q = rms_norm(q.reshape(Bsz, S, SWA_HEADS, SWA_HEAD_DIM).astype(f32), qn_w)
    k = rms_norm(k.reshape(Bsz, S, SWA_KV_HEADS, SWA_HEAD_DIM).astype(f32), kn_w)
    v = v.reshape(Bsz, S, SWA_KV_HEADS, SWA_HEAD_DIM).astype(f32)
    inv_freq = ROPE_THETA ** (-jnp.arange(0, ROPE_DIM, 2, dtype=f32) / ROPE_DIM)
    ang = positions.astype(f32)[..., None] * inv_freq
    cos, sin = jnp.cos(ang)[:, :, None, :], jnp.sin(ang)[:, :, None, :]
    q = rope_partial(q, cos, sin) * SWA_HEAD_DIM ** -0.5
    k = rope_partial(k, cos, sin)
    qb = q.reshape(Bsz, N, T, SWA_KV_HEADS, G, SWA_HEAD_DIM)
    kw = with_prev_block(k.reshape(Bsz, N, T, SWA_KV_HEADS, SWA_HEAD_DIM))
    vw = with_prev_block(v.reshape(Bsz, N, T, SWA_KV_HEADS, SWA_HEAD_DIM))
    s = jnp.einsum('bnqkgd,bnckd->bkgnqc', qb, kw)
    qpos = jnp.arange(N)[:, None] * T + jnp.arange(T)[None, :]
    kpos = (jnp.arange(N)[:, None] - 1) * T + jnp.arange(2 * T)[None, :]
    diff = qpos[:, :, None] - kpos[:, None, :]
    mask = (diff >= 0) & (diff < SWA_WINDOW) & (kpos[:, None, :] >= 0)
    s = jnp.where(mask, s, -jnp.inf)
    sink = sinks.astype(f32).reshape(SWA_KV_HEADS, G)[None, :, :, None, None, None]
    m = jnp.maximum(jnp.max(s, axis=-1, keepdims=True), sink)
    p = jnp.exp(s - m)
    denom = jnp.sum(p, axis=-1, keepdims=True) + jnp.exp(sink - m)
    o = jnp.einsum('bkgnqc,bnckd->bkgnqd', p, vw) / denom
    o = o.transpose(0, 3, 4, 1, 2, 5).reshape(Bsz, S, SWA_HEADS * SWA_HEAD_DIM)
    return o


def setup_inputs(seed: int = 0) -> dict:
    key = jax.random.key(seed)
    ks = jax.random.split(key, 20)
    f32 = jnp.float32
    nrm = lambda k, shape, scale: jax.random.normal(k, shape, f32) * scale
    x = jax.random.normal(ks[0], (BATCH, SEQ, D_MODEL), f32)
    positions = jnp.broadcast_to(jnp.arange(SEQ, dtype=jnp.int32)[None, :], (BATCH, SEQ))
    return {
        "x": x,
        "positions": positions,
        "norm1_w": 1.0 + nrm(ks[1], (DEPTH, D_MODEL), 0.02),
        "w_in": nrm(ks[2], (DEPTH, D_MODEL, N_IN), D_MODEL ** -0.5),
        "conv_w": nrm(ks[3], (DEPTH, CONV_WIDTH, CONV_DIM), CONV_WIDTH ** -0.5),
        "conv_b": nrm(ks[4], (DEPTH, CONV_DIM), 0.02),
        "gla_wa2": nrm(ks[5], (DEPTH, GLA_RANK, GLA_HEADS * GLA_DK), GLA_RANK ** -0.5),
        "gla_ba": nrm(ks[6], (DEPTH, GLA_HEADS * GLA_DK), 0.1),
        "gla_onorm_w": 1.0 + nrm(ks[7], (DEPTH, GLA_DV), 0.02),
        "q_norm_w": 1.0 + nrm(ks[8], (DEPTH, SWA_HEAD_DIM), 0.02),
        "k_norm_w": 1.0 + nrm(ks[9], (DEPTH, SWA_HEAD_DIM), 0.02),
        "sinks": nrm(ks[10], (DEPTH, SWA_HEADS), 0.5),
        "w_branch": nrm(ks[11], (DEPTH, N_BRANCHES, BRANCH_WIDTH, D_MODEL), BRANCH_WIDTH ** -0.5),
        "w_o": nrm(ks[12], (DEPTH, D_MODEL, D_MODEL), D_MODEL ** -0.5),
        "norm2_w": 1.0 + nrm(ks[13], (DEPTH, D_MODEL), 0.02),
        "w_up": nrm(ks[14], (DEPTH, D_MODEL, D_FF), D_MODEL ** -0.5),
        "w_down": nrm(ks[15], (DEPTH, D_FF, D_MODEL), D_FF ** -0.5),
    }


def reference(x, positions, norm1_w, w_in, conv_w, conv_b, gla_wa2, gla_ba, gla_onorm_w,
              q_norm_w, k_norm_w, sinks, w_branch, w_o, norm2_w, w_up, w_down):
    Bsz, S, D = x.shape
    split_idx = np.cumsum(SPLITS)[:-1].tolist()
    for l in range(DEPTH):
        u = rms_norm(x, norm1_w[l])
        proj = u @ w_in[l]
        (cx, cb, cc, gq, gk, gv, gr, ga, sq, sk, sv, gates) = jnp.split(proj, split_idx, axis=-1)
        ya = short_conv_mixer(cx, cb, cc, conv_w[l], conv_b[l])
        yb = gla_mixer(gq, gk, gv, gr, ga, gla_wa2[l], gla_ba[l], gla_onorm_w[l])
        yc = swa_mixer(sq, sk, sv, positions, q_norm_w[l], k_norm_w[l], sinks[l])
        ybr = jnp.stack([ya.astype(x.dtype), yb.astype(x.dtype), yc.astype(x.dtype)], axis=2)
        branch = jnp.einsum('bsgc,gcd->bsgd', ybr, w_branch[l])
        gate = jax.nn.sigmoid(gates.reshape(Bsz, S, N_BRANCHES, D))
        mixed = jnp.sum(gate * branch, axis=2)
        x = x + mixed @ w_o[l]
        h = rms_norm(x, norm2_w[l])
        x = x + jnp.square(jax.nn.relu(h @ w_up[l])) @ w_down[l]
    return x
```

```cpp
#include <hip/hip_runtime.h>
#include <hip/hip_cooperative_groups.h>
#include <cstdio>
#include <cstdint>
namespace cg = cooperative_groups;

#define LAS __attribute__((address_space(3)))
typedef unsigned short bf16_t;
typedef short bf16x8 __attribute__((ext_vector_type(8)));
typedef float f32x4 __attribute__((ext_vector_type(4)));
typedef unsigned u32x4 __attribute__((ext_vector_type(4)));
typedef unsigned u32x2 __attribute__((ext_vector_type(2)));
typedef int i32x4 __attribute__((ext_vector_type(4)));
typedef int i32x8 __attribute__((ext_vector_type(8)));

constexpr int M = 32768, SEQ = 2048, D = 1024, NPROJ = 4096, NGATE = 3072, DFF = 4096, NIN = 6928, YW = 1536;
constexpr float EPS = 1e-6f;
constexpr int C_CX = 0, C_CB = 512, C_CC = 1024, C_GQ = 1536, C_GK = 1792, C_GV = 2048, C_GR = 2560, C_Z = 3072, C_SQ = 3328, C_SK = 3840, C_SV = 3968;
constexpr size_t MiB = 1u << 20;
constexpr size_t WS_SSA = 0, WS_SSB = 1 * MiB, WS_DEC = 2 * MiB, WS_WIN = 4 * MiB, WS_WG = 12 * MiB, WS_WBR = 18 * MiB, WS_WO = 21 * MiB, WS_WUP = 23 * MiB, WS_WDN = 31 * MiB;
constexpr size_t WS_XB = 40 * MiB, WS_Y = 104 * MiB, WS_S = 200 * MiB, WS_PROJ = 232 * MiB, WS_MIXED = WS_PROJ + 192 * MiB, WS_END = 496 * MiB;
constexpr int LDS_BYTES = 147456;
constexpr size_t DO_W1 = 32 * MiB, DO_AGG = 68 * MiB, DO_PC = 76 * MiB, DO_AGGD = 77 * MiB, WS_WDN1 = 488 * MiB;

typedef float f32x2_t __attribute__((ext_vector_type(2))); typedef __bf16 bf16x2_t __attribute__((ext_vector_type(2)));
__device__ __forceinline__ unsigned cvt_pk_bf16(float lo, float hi) { f32x2_t v = {lo, hi}; bf16x2_t b = __builtin_convertvector(v, bf16x2_t); return __builtin_bit_cast(unsigned, b); }
__device__ __forceinline__ float bf2f(unsigned short h) { return __uint_as_float((unsigned)h << 16); }
__device__ __forceinline__ float bflo(unsigned w) { return __uint_as_float(w << 16); }
__device__ __forceinline__ float bfhi(unsigned w) { return __uint_as_float(w & 0xffff0000u); }
__device__ __forceinline__ float fsigmoid(float v) { return __builtin_amdgcn_rcpf(1.f + __expf(-v)); }
__device__ __forceinline__ float glog_of(float z) { return (fminf(z, 0.f) - __logf(1.f + __expf(-fabsf(z)))) * 0.0625f; }
#define LDS_WAIT() asm volatile("s_waitcnt lgkmcnt(0)" ::: "memory")
__device__ __forceinline__ unsigned pk4_fp8(float a, float b, float c, float d) { int w = __builtin_amdgcn_cvt_pk_fp8_f32(a, b, 0, false); w = __builtin_amdgcn_cvt_pk_fp8_f32(c, d, w, true); return (unsigned)w; }
constexpr float WG8_SCALE = 64.0f;

namespace pg8 {
constexpr int BM = 256, BK = 64, HALF = 128, HTB = HALF * BK * 2, NXCD = 8, WGM = 8;
__host__ __device__ __forceinline__ int lds_byte(int r, int c) { const int st = (r >> 4) * 2 + (c >> 5), rr = r & 15, cc = c & 31, ob = rr * 64 + cc * 2; return st * 1024 + (ob ^ (((ob >> 9) & 1) << 5)); }
__host__ __device__ __forceinline__ void stage_rc(int b, int& R, int& C) { const int st = b / 1024, sb = b % 1024, swz = sb ^ (((sb >> 9) & 1) << 5); R = (st >> 1) * 16 + swz / 64; C = (st & 1) * 32 + (swz % 64) / 2; }
__host__ __device__ __forceinline__ int perm32(int rho) { const int n = rho >> 4, i = rho & 15; return 8 * (i >> 2) + 4 * n + (i & 3); }
struct Unit { int pm, pn; };
struct Gemm { const bf16_t* A; const bf16_t* Bt; int lda, ldb, K; };
struct StaticOrder {
    int nM, nN, nwg, G, c;
    __device__ void init(int Mr, int N, int G_, int c_) { nM = Mr / BM; nN = N / BM; nwg = nM * nN; G = G_; c = c_; }
    __device__ bool next(int i, Unit& u) const {
        const long L = (long)i * G + c; if (L >= nwg) return false;
        int wgid = (int)L; { const int q = nwg / NXCD, r = nwg % NXCD, xcd = wgid % NXCD, off = wgid / NXCD; wgid = (xcd < r ? xcd * (q + 1) : r * (q + 1) + (xcd - r) * q) + off; }
        const int nig = WGM * nN, gid = wgid / nig, fm = gid * WGM, gsz = (nM - fm) < WGM ? (nM - fm) : WGM;
        u.pm = fm + ((wgid % nig) % gsz); u.pn = (wgid % nig) / gsz; return true;
    }
    __device__ __forceinline__ void ptrs(const Gemm& g, const Unit& u, const char*& cA, const char*& cB) const {
        cA = (const char*)g.A + (size_t)u.pm * BM * g.lda * 2; cB = (const char*)g.Bt + (size_t)u.pn * BM * g.ldb * 2; }
};
struct BrOrder {
    StaticOrder base;
    __device__ void init(int Mr, int G_, int c_) { base.init(Mr, 1024, G_, c_); }
    __device__ bool next(int i, Unit& u) const { Unit b; const int ib = i / 3, g = i - ib * 3; if (!base.next(ib, b)) return false; u.pm = b.pm; u.pn = g * 4 + b.pn; return true; }
    __device__ __forceinline__ void ptrs(const Gemm& g, const Unit& u, const char*& cA, const char*& cB) const {
        cA = (const char*)g.A + (size_t)u.pm * BM * g.lda * 2 + (size_t)(u.pn >> 2) * 512 * 2; cB = (const char*)g.Bt + (size_t)u.pn * BM * g.ldb * 2; }
};

struct GateOrder {
    StaticOrder base;
    __device__ void init(int Mr, int G_, int c_) { base.init(Mr, 1024, G_, c_); }
    __device__ bool next(int i, Unit& u) const { Unit b; const int ib = i / 3, g = i - ib * 3; if (!base.next(ib, b)) return false; u.pm = b.pm; u.pn = g * 4 + b.pn; return true; }
    __device__ __forceinline__ void ptrs(const Gemm& g, const Unit& u, const char*& cA, const char*& cB) const {
        cA = (const char*)g.A + (size_t)u.pm * BM * g.lda * 2; cB = (const char*)g.Bt + (size_t)u.pn * BM * g.ldb * 2; }
};
template <class Epi, class Sched, bool FP8 = false>
__device__ __forceinline__ void gemm_phase(LAS unsigned char* lds, const Gemm g, const Sched& S, const Epi& E) {
    int tid_ = threadIdx.x; asm volatile("" : "+v"(tid_));
    const int tid = tid_, wid = __builtin_amdgcn_readfirstlane(tid >> 6), lane = tid & 63, wr = wid >> 2, wc = wid & 3, fr = lane & 15, fq = lane >> 4;
    const int K = g.K, nt = K / BK;
    unsigned voffA[2], voffB[2];
#pragma unroll
    for (int i = 0; i < 2; ++i) { int R, C; stage_rc(tid * 16 + i * 8192, R, C); const int Rb = Epi::PERM ? ((R & ~31) + perm32(R & 31)) : R;
        voffA[i] = (unsigned)(R * g.lda + C) * 2u; voffB[i] = (unsigned)(Rb * g.ldb + C) * 2u; }
    const size_t kstep = (size_t)(BK * 2);
    const size_t hstepA = (size_t)HALF * g.lda * 2, hstepB = (size_t)HALF * g.ldb * 2;
    const unsigned ldsw = (unsigned)wid * 1024u;
    const int aoff = lds_byte(wr * 64 + fr, fq * 8), boff = lds_byte(wc * 32 + fr, fq * 8);
#define PG8_SA(b, h) (((b) * 2 + (h)) * HTB)
#define PG8_SB(b, h) ((4 + (b) * 2 + (h)) * HTB)
#define PG8_STAGE(bufoff, gbase, voff) do { _Pragma("unroll") for (int _i = 0; _i < 2; ++_i) \
        __builtin_amdgcn_global_load_lds((const unsigned*)((const char*)(gbase) + (voff)[_i]), (LAS unsigned*)(lds + (bufoff) + ldsw + _i * 8192), 16, 0, 0); } while (0)
#define PG8_LDA(dst, b, h) do { _Pragma("unroll") for (int m = 0; m < 4; ++m) _Pragma("unroll") for (int k = 0; k < 2; ++k) dst[m][k] = *(const LAS bf16x8*)(lds + PG8_SA(b, h) + aoff + m * 2048 + k * 1024); } while (0)
#define PG8_LDB(dst, b, h) do { _Pragma("unroll") for (int n = 0; n < 2; ++n) _Pragma("unroll") for (int k = 0; k < 2; ++k) dst[n][k] = *(const LAS bf16x8*)(lds + PG8_SB(b, h) + boff + n * 2048 + k * 1024); } while (0)
#define PG8_MMA(ai, bj, At, Bt) do { __builtin_amdgcn_s_setprio(1); _Pragma("unroll") for (int m = 0; m < 4; ++m) _Pragma("unroll") for (int n = 0; n < 2; ++n) { \
        if constexpr (FP8) { const i32x8 b8_ = __builtin_shufflevector(__builtin_bit_cast(i32x4, Bt[n][0]), __builtin_bit_cast(i32x4, Bt[n][1]), 0, 1, 2, 3, 4, 5, 6, 7); \
            const i32x8 a8_ = __builtin_shufflevector(__builtin_bit_cast(i32x4, At[m][0]), __builtin_bit_cast(i32x4, At[m][1]), 0, 1, 2, 3, 4, 5, 6, 7); \
            asm volatile("v_mfma_scale_f32_16x16x128_f8f6f4 %0, %1, %2, %0, %3, %3 op_sel_hi:[0,0,0]" : "+v"(acc[ai][bj][m][n]) : "v"(b8_), "v"(a8_), "v"(sc8_)); } \
        else { _Pragma("unroll") for (int k = 0; k < 2; ++k) acc[ai][bj][m][n] = __builtin_amdgcn_mfma_f32_16x16x32_bf16(Bt[n][k], At[m][k], acc[ai][bj][m][n], 0, 0, 0); } } \
        __builtin_amdgcn_s_setprio(0); } while (0)
#define PG8_WAIT_V(n) asm volatile("s_waitcnt vmcnt(" #n ")" ::: "memory")
#define PG8_WAIT_L(n) asm volatile("s_waitcnt lgkmcnt(" #n ")" ::: "memory")
#define PG8_BAR __builtin_amdgcn_s_barrier()
#define PG8_SCHED __builtin_amdgcn_sched_barrier(0)
    Unit cur, nxt; int ui = 0;
    if (!S.next(0, cur)) return;
    f32x4 acc[2][2][4][2];
#pragma unroll
    for (int a = 0; a < 2; ++a)
#pragma unroll
        for (int b = 0; b < 2; ++b)
#pragma unroll
            for (int m = 0; m < 4; ++m)
#pragma unroll
                for (int n = 0; n < 2; ++n) acc[a][b][m][n] = (f32x4){0.f, 0.f, 0.f, 0.f};
    bf16x8 At[4][2], B0[2][2], B1[2][2];
    const int sc8_ = 0x7f7f7f7f;
    (void)sc8_;
    const char* cA; const char* cB; S.ptrs(g, cur, cA, cB);
    u32x4 itmp[2][4][2];
    if constexpr (Epi::INIT) E.init_load(itmp, cur, wr, wc, fr, fq);
    PG8_STAGE(PG8_SB(0, 0), cB, voffB); PG8_STAGE(PG8_SB(0, 1), cB + hstepB, voffB); PG8_STAGE(PG8_SA(0, 0), cA, voffA); PG8_STAGE(PG8_SA(0, 1), cA + hstepA, voffA);
    E.table_fill(lds, S, tid);
    if (wr == 1) PG8_BAR;
    PG8_WAIT_V(2); PG8_BAR;
    PG8_STAGE(PG8_SB(1, 0), cB + kstep, voffB); PG8_STAGE(PG8_SA(1, 0), cA + kstep, voffA); PG8_STAGE(PG8_SB(1, 1), cB + hstepB + kstep, voffB);
    PG8_WAIT_V(6); PG8_BAR;
    if constexpr (Epi::INIT) E.init_apply(acc, itmp);
    for (;;) {
        const bool has_next = S.next(ui + 1, nxt);
        const char* nA = cA; const char* nB = cB; if (has_next) S.ptrs(g, nxt, nA, nB);
#pragma nounroll
        for (int t = 0; t < nt; t += 2) {
            const bool last = (t == nt - 2);
            const char* a1 = cA + (size_t)(t + 1) * kstep;
            const char* a2 = last ? nA : cA + (size_t)(t + 2) * kstep; const char* b2 = last ? nB : cB + (size_t)(t + 2) * kstep;
            const char* a3 = a2 + kstep; const char* b3 = b2 + kstep;
            PG8_LDB(B0, 0, 0); PG8_LDB(B1, 0, 1); PG8_SCHED; PG8_LDA(At, 0, 0); PG8_STAGE(PG8_SA(1, 1), a1 + hstepA, voffA);
            PG8_WAIT_V(8); PG8_WAIT_L(0); PG8_BAR; PG8_MMA(0, 0, At, B0); PG8_MMA(0, 1, At, B1); PG8_BAR; PG8_SCHED;
            PG8_LDA(At, 0, 1); PG8_STAGE(PG8_SB(0, 0), b2, voffB); PG8_STAGE(PG8_SB(0, 1), b2 + hstepB, voffB); PG8_STAGE(PG8_SA(0, 0), a2, voffA);
            PG8_WAIT_V(8); PG8_WAIT_L(0); PG8_BAR; PG8_MMA(1, 0, At, B0); PG8_MMA(1, 1, At, B1); PG8_BAR; PG8_SCHED;
            PG8_LDB(B0, 1, 0); PG8_LDB(B1, 1, 1); PG8_SCHED; PG8_LDA(At, 1, 0); PG8_STAGE(PG8_SA(0, 1), a2 + hstepA, voffA);
            PG8_WAIT_V(8); PG8_WAIT_L(0); PG8_BAR; PG8_MMA(0, 0, At, B0); PG8_MMA(0, 1, At, B1); PG8_BAR; PG8_SCHED;
            PG8_LDA(At, 1, 1); PG8_STAGE(PG8_SB(1, 0), b3, voffB); PG8_STAGE(PG8_SB(1, 1), b3 + hstepB, voffB); PG8_STAGE(PG8_SA(1, 0), a3, voffA);
            PG8_WAIT_V(8); PG8_WAIT_L(0); PG8_BAR; PG8_MMA(1, 0, At, B0); PG8_MMA(1, 1, At, B1); PG8_BAR; PG8_SCHED;
        }
        if (wr == 0) PG8_BAR;
        if constexpr (FP8) asm volatile("s_nop 15\n\ts_nop 15" ::: "memory");
        E(acc, cur, wr, wc, fr, fq, ui, lds);
        if (!has_next) break;
        if (!E.keep_acc(cur)) {
#pragma unroll
        for (int a = 0; a < 2; ++a)
#pragma unroll
            for (int b = 0; b < 2; ++b)
#pragma unroll
                for (int m = 0; m < 4; ++m)
#pragma unroll
                    for (int n = 0; n < 2; ++n) acc[a][b][m][n] = (f32x4){0.f, 0.f, 0.f, 0.f};
        }
        cur = nxt; cA = nA; cB = nB; ++ui;
        if (wr == 1) PG8_BAR;
    }
    PG8_WAIT_V(0);
    PG8_BAR;
#undef PG8_SA
#undef PG8_SB
#undef PG8_STAGE
#undef PG8_LDA
#undef PG8_LDB
#undef PG8_MMA
#undef PG8_WAIT_V
#undef PG8_WAIT_L
#undef PG8_BAR
#undef PG8_SCHED
}

__device__ __forceinline__ u32x4 pack8(const f32x4 v0, const f32x4 v1) { u32x4 w; w.x = cvt_pk_bf16(v0[0], v0[1]); w.y = cvt_pk_bf16(v0[2], v0[3]); w.z = cvt_pk_bf16(v1[0], v1[1]); w.w = cvt_pk_bf16(v1[2], v1[3]); return w; }
constexpr int RSTD_OFF = 131072 + 1024;
#define LOAD_RSTD(rs, tab, ui, wr, fr) float rs[2][4]; { const LAS float* t_ = (tab) + (ui) * 256 + (wr) * 64 + (fr); \
    _Pragma("unroll") for (int ai = 0; ai < 2; ++ai) _Pragma("unroll") for (int m = 0; m < 4; ++m) rs[ai][m] = t_[ai * HALF + m * 16]; }
template <class Sched>
__device__ __forceinline__ void rstd_table_fill(LAS unsigned char* lds, const float* ss, const Sched& S, int tid) {
    LAS float* tab = (LAS float*)(lds + RSTD_OFF);
    const int t = tid & 255, half = tid >> 8;
#pragma unroll
    for (int i = 0; i < 4; ++i) { Unit u; const int ui = i * 2 + half;
        if (S.next(ui, u)) tab[ui * 256 + t] = rsqrtf(ss[u.pm * BM + t] * (1.0f / 1024.0f) + EPS); }
    __syncthreads();
}

struct EpiProj {
    static constexpr bool PERM = true, INIT = false;
    bf16_t* O; const float* ss; const float* ba;
    __device__ __forceinline__ bool keep_acc(const Unit&) const { return false; }
    template <class Sched_> __device__ __forceinline__ void table_fill(LAS unsigned char* lds, const Sched_& S, int tid) const { rstd_table_fill(lds, ss, S, tid); }
    __device__ __forceinline__ void operator()(f32x4 (&acc)[2][2][4][2], const Unit& u, int wr, int wc, int fr, int fq, int ui, LAS unsigned char* lds) const {
        const int row0 = u.pm * BM + wr * 64 + fr, col0 = u.pn * BM + wc * 32 + 8 * fq;
        const bool isz = (u.pn == 12);
        LOAD_RSTD(rs, (const LAS float*)(lds + RSTD_OFF), ui, wr, fr)
        f32x4 bz[2][2];
#pragma unroll
        for (int bj = 0; bj < 2; ++bj)
#pragma unroll
            for (int n = 0; n < 2; ++n) bz[bj][n] = isz ? *(const f32x4*)(ba + (col0 - C_Z) + bj * HALF + 4 * n) : (f32x4){0.f, 0.f, 0.f, 0.f};
#pragma unroll
        for (int ai = 0; ai < 2; ++ai)
#pragma unroll
            for (int m = 0; m < 4; ++m) { const int row = row0 + ai * HALF + m * 16; const float r = rs[ai][m]; bf16_t* rowp = O + (size_t)row * NPROJ + col0;
#pragma unroll
                for (int bj = 0; bj < 2; ++bj) { f32x4 v0 = acc[ai][bj][m][0] * r, v1 = acc[ai][bj][m][1] * r;
                    if (isz) { v0 = v0 + bz[bj][0]; v1 = v1 + bz[bj][1];
#pragma unroll
                        for (int j = 0; j < 4; ++j) { v0[j] = glog_of(v0[j]); v1[j] = glog_of(v1[j]); } }
                    *(u32x4*)(rowp + bj * HALF) = pack8(v0, v1); } }
    }
};
struct EpiGate {
    static constexpr bool PERM = true, INIT = false;
    bf16_t* O; const float* ss; float zscale;
    __device__ __forceinline__ bool keep_acc(const Unit&) const { return false; }
    template <class Sched_> __device__ __forceinline__ void table_fill(LAS unsigned char* lds, const Sched_& S, int tid) const { rstd_table_fill(lds, ss, S, tid); }
    __device__ __forceinline__ void operator()(f32x4 (&acc)[2][2][4][2], const Unit& u, int wr, int wc, int fr, int fq, int ui, LAS unsigned char* lds) const {
        const int row0 = u.pm * BM + wr * 64 + fr, col0 = u.pn * BM + wc * 32 + 8 * fq;
        LOAD_RSTD(rs, (const LAS float*)(lds + RSTD_OFF), ui, wr, fr)
#pragma unroll
        for (int ai = 0; ai < 2; ++ai)
#pragma unroll
            for (int m = 0; m < 4; ++m) { const int row = row0 + ai * HALF + m * 16; const float r = rs[ai][m]; bf16_t* rowp = O + (size_t)row * NGATE + col0;
#pragma unroll
                for (int bj = 0; bj < 2; ++bj) { const float rz = r * zscale; f32x4 v0 = acc[ai][bj][m][0] * rz, v1 = acc[ai][bj][m][1] * rz;
#pragma unroll
                    for (int j = 0; j < 4; ++j) { v0[j] = fminf(1.f + __expf(-v0[j]), 1e30f); v1[j] = fminf(1.f + __expf(-v1[j]), 1e30f); }
                    *(u32x4*)(rowp + bj * HALF) = pack8(v0, v1); } }
    }
};
struct EpiUp {
    static constexpr bool PERM = true, INIT = false;
    bf16_t* O; const float* ss;
    __device__ __forceinline__ bool keep_acc(const Unit&) const { return false; }
    template <class Sched_> __device__ __forceinline__ void table_fill(LAS unsigned char* lds, const Sched_& S, int tid) const { rstd_table_fill(lds, ss, S, tid); }
    __device__ __forceinline__ void operator()(f32x4 (&acc)[2][2][4][2], const Unit& u, int wr, int wc, int fr, int fq, int ui, LAS unsigned char* lds) const {
        const int row0 = u.pm * BM + wr * 64 + fr, col0 = u.pn * BM + wc * 32 + 8 * fq;
        LOAD_RSTD(rs, (const LAS float*)(lds + RSTD_OFF), ui, wr, fr)
#pragma unroll
        for (int ai = 0; ai < 2; ++ai)
#pragma unroll
            for (int m = 0; m < 4; ++m) { const int row = row0 + ai * HALF + m * 16; const float r = rs[ai][m]; bf16_t* rowp = O + (size_t)row * DFF + col0;
#pragma unroll
                for (int bj = 0; bj < 2; ++bj) { f32x4 v0 = acc[ai][bj][m][0] * r, v1 = acc[ai][bj][m][1] * r;
#pragma unroll
                    for (int j = 0; j < 4; ++j) { const float a = fmaxf(v0[j], 0.f), b = fmaxf(v1[j], 0.f); v0[j] = a * a; v1[j] = b * b; }
                    *(u32x4*)(rowp + bj * HALF) = pack8(v0, v1); } }
    }
};
struct EpiBr {
    static constexpr bool PERM = true, INIT = false;
    const bf16_t* gates; bf16_t* mixed;
    __device__ __forceinline__ bool keep_acc(const Unit& u) const { return (u.pn >> 2) < 2; }
    template <class Sched_> __device__ __forceinline__ void table_fill(LAS unsigned char*, const Sched_&, int) const {}
    __device__ __forceinline__ void operator()(f32x4 (&acc)[2][2][4][2], const Unit& u, int wr, int wc, int fr, int fq, int ui, LAS unsigned char* lds) const {
        const int g = u.pn >> 2;
        const int row0 = u.pm * BM + wr * 64 + fr, col0 = (u.pn & 3) * BM + wc * 32 + 8 * fq;
        u32x4 ga[2][2][2], gb[2][2][2];
#define BR_LOAD(slot, q) do { _Pragma("unroll") for (int m2 = 0; m2 < 2; ++m2) _Pragma("unroll") for (int bj = 0; bj < 2; ++bj) { \
            const bf16_t* gp = gates + (size_t)(row0 + ((q) >> 1) * HALF + (((q) & 1) * 2 + m2) * 16) * NGATE + g * 1024 + col0 + bj * HALF; \
            ga[slot][m2][bj] = *(const u32x4*)gp; gb[slot][m2][bj] = (g < 2) ? *(const u32x4*)(gp + 1024) : (u32x4){0x3f803f80u, 0x3f803f80u, 0x3f803f80u, 0x3f803f80u}; } } while (0)
        BR_LOAD(0, 0); BR_LOAD(1, 1);
#pragma unroll
        for (int q = 0; q < 4; ++q) { const int ai = q >> 1, sl = q & 1;
#pragma unroll
            for (int m2 = 0; m2 < 2; ++m2)
#pragma unroll
                for (int bj = 0; bj < 2; ++bj) { const int m = (q & 1) * 2 + m2, row = row0 + ai * HALF + m * 16; const u32x4 a = ga[sl][m2][bj], b = gb[sl][m2][bj];
                    float f[8];
#pragma unroll
                    for (int e = 0; e < 4; ++e) { f[2 * e] = bflo(b[e]) * __builtin_amdgcn_rcpf(bflo(a[e])); f[2 * e + 1] = bfhi(b[e]) * __builtin_amdgcn_rcpf(bfhi(a[e])); }
                    f32x4 v0 = acc[ai][bj][m][0], v1 = acc[ai][bj][m][1];
                    v0[0] *= f[0]; v0[1] *= f[1]; v0[2] *= f[2]; v0[3] *= f[3]; v1[0] *= f[4]; v1[1] *= f[5]; v1[2] *= f[6]; v1[3] *= f[7];
                    if (g < 2) { acc[ai][bj][m][0] = v0; acc[ai][bj][m][1] = v1; }
                    else *(u32x4*)(mixed + (size_t)row * D + col0 + bj * HALF) = pack8(v0, v1); }
            asm volatile("" ::: "memory");
            if (q == 0) BR_LOAD(0, 2);
            if (q == 1) BR_LOAD(1, 3);
        }
#undef BR_LOAD
    }
};
struct EpiRes {
    static constexpr bool PERM = true, INIT = true;
    float* xout; bf16_t* xb; float* ss; unsigned char* xb8;
    __device__ __forceinline__ bool keep_acc(const Unit&) const { return false; }
    template <class Sched_> __device__ __forceinline__ void table_fill(LAS unsigned char*, const Sched_&, int) const {}
    __device__ __forceinline__ void init_load(u32x4 (&t)[2][4][2], const Unit& u, int wr, int wc, int fr, int fq) const {
        const int row0 = u.pm * BM + wr * 64 + fr, col0 = u.pn * BM + wc * 32 + 8 * fq;
#pragma unroll
        for (int ai = 0; ai < 2; ++ai)
#pragma unroll
            for (int m = 0; m < 4; ++m)
#pragma unroll
                for (int bj = 0; bj < 2; ++bj) t[ai][m][bj] = *(const u32x4*)(xb + (size_t)(row0 + ai * HALF + m * 16) * D + col0 + bj * HALF);
    }
    __device__ __forceinline__ void init_apply(f32x4 (&acc)[2][2][4][2], const u32x4 (&t)[2][4][2]) const {
#pragma unroll
        for (int ai = 0; ai < 2; ++ai)
#pragma unroll
            for (int m = 0; m < 4; ++m)
#pragma unroll
                for (int bj = 0; bj < 2; ++bj) { const u32x4 w = t[ai][m][bj];
                    acc[ai][bj][m][0] = (f32x4){bflo(w.x), bfhi(w.x), bflo(w.y), bfhi(w.y)}; acc[ai][bj][m][1] = (f32x4){bflo(w.z), bfhi(w.z), bflo(w.w), bfhi(w.w)}; }
    }
    __device__ __forceinline__ void operator()(f32x4 (&acc)[2][2][4][2], const Unit& u, int wr, int wc, int fr, int fq, int ui, LAS unsigned char* lds) const {
        const int row0 = u.pm * BM + wr * 64 + fr, col0 = u.pn * BM + wc * 32 + 8 * fq;
#pragma unroll
        for (int ai = 0; ai < 2; ++ai) {
            u32x4 xv[4][2];
#pragma unroll
            for (int m = 0; m < 4; ++m)
#pragma unroll
                for (int bj = 0; bj < 2; ++bj) xv[m][bj] = (ui > 0) ? *(const u32x4*)(xb + (size_t)(row0 + ai * HALF + m * 16) * D + col0 + bj * HALF) : (u32x4){0u, 0u, 0u, 0u};
#pragma unroll
            for (int m = 0; m < 4; ++m) { const int row = row0 + ai * HALF + m * 16; float sq = 0.f;
#pragma unroll
                for (int bj = 0; bj < 2; ++bj) { const size_t off = (size_t)row * D + col0 + bj * HALF; const u32x4 w = xv[m][bj];
                    f32x4 x0 = acc[ai][bj][m][0], x1 = acc[ai][bj][m][1];
                    x0[0] += bflo(w.x); x0[1] += bfhi(w.x); x0[2] += bflo(w.y); x0[3] += bfhi(w.y); x1[0] += bflo(w.z); x1[1] += bfhi(w.z); x1[2] += bflo(w.w); x1[3] += bfhi(w.w);
                    if (xout) { *(f32x4*)(xout + off) = x0; *(f32x4*)(xout + off + 4) = x1; }
                    sq += (x0[0] * x0[0] + x0[1] * x0[1]) + (x0[2] * x0[2] + x0[3] * x0[3]) + (x1[0] * x1[0] + x1[1] * x1[1]) + (x1[2] * x1[2] + x1[3] * x1[3]);
                    if (!xout) *(u32x4*)(xb + off) = pack8(x0, x1);
                    if (xb8) { u32x2 o8; o8.x = pk4_fp8(x0[0], x0[1], x0[2], x0[3]); o8.y = pk4_fp8(x1[0], x1[1], x1[2], x1[3]); *(u32x2*)(xb8 + off) = o8; } }
                sq += __shfl_xor(sq, 16); sq += __shfl_xor(sq, 32);
                if (fq == 0 && !xout) (void)__hip_atomic_fetch_add(ss + row, sq, __ATOMIC_RELAXED, __HIP_MEMORY_SCOPE_AGENT); }
            asm volatile("" ::: "memory");
        }
    }
};
}

struct Args {
    const float *x; const int* pos; const float *norm1_w, *w_in, *conv_w, *conv_b, *gla_wa2, *gla_ba, *gla_onorm_w, *q_norm_w, *k_norm_w, *sinks, *w_branch, *w_o, *norm2_w, *w_up, *w_down;
    float* out; unsigned char* ws;
};


__device__ __forceinline__ unsigned char* wptr(const Args& a, unsigned char* ws, int l, size_t off) { return l == 0 ? ws + off : (unsigned char*)a.out + DO_W1 + (off - WS_WIN); }
__device__ __forceinline__ unsigned char* wdn_ptr(unsigned char* ws, int l) { return l == 0 ? ws + WS_WDN : ws + WS_WDN1; }
template <class F>
__device__ __forceinline__ void transpose_items(F src4, int K, int N, bf16_t* WT, LAS float* scr, int gw, int NGW, int lane) {
    const int nblk = N / 32, nitems = (K / 64) * nblk;
    const int r8 = lane >> 3, c4 = lane & 7;
    for (int it = gw; it < nitems; it += NGW) {
        const int kb = it / nblk, nb = it - kb * nblk, k0 = 64 * kb, n0 = 32 * nb;
        f32x4 v[8];
#pragma unroll
        for (int i = 0; i < 8; ++i) v[i] = src4(k0 + i * 8 + r8, n0 + c4 * 4);
#pragma unroll
        for (int i = 0; i < 8; ++i) { LAS float* d = scr + (i * 8 + r8) * 33 + c4 * 4; d[0] = v[i][0]; d[1] = v[i][1]; d[2] = v[i][2]; d[3] = v[i][3]; }
        LDS_WAIT();
        const int c = lane & 7;
#pragma unroll
        for (int j = 0; j < 4; ++j) { const int n = (lane >> 3) + 8 * j; const LAS float* sp = scr + (8 * c) * 33 + n;
            u32x4 o; o.x = cvt_pk_bf16(sp[0 * 33], sp[1 * 33]); o.y = cvt_pk_bf16(sp[2 * 33], sp[3 * 33]); o.z = cvt_pk_bf16(sp[4 * 33], sp[5 * 33]); o.w = cvt_pk_bf16(sp[6 * 33], sp[7 * 33]);
            *(u32x4*)(WT + (size_t)(n0 + n) * K + k0 + 8 * c) = o; }
        LDS_WAIT();
    }
}
__device__ __forceinline__ void conv_w_in_main(const Args& a, unsigned char* ws, LAS float* scr, int l, int gw, int NGW, int lane) {
    const float* W = a.w_in + (size_t)l * D * NIN; const float* nw = a.norm1_w + l * D; const float* wa2 = a.gla_wa2 + l * 16 * 256;
    auto src = [=](int k, int n) -> f32x4 {
        const float* wr = W + (size_t)k * NIN; f32x4 v;
        if (n < C_Z) v = *(const f32x4*)(wr + n);
        else if (n < C_SQ) { v = (f32x4){0.f, 0.f, 0.f, 0.f};
#pragma unroll
            for (int r4 = 0; r4 < 4; ++r4) { const f32x4 g = *(const f32x4*)(wr + 3072 + r4 * 4);
#pragma unroll
                for (int rr = 0; rr < 4; ++rr) v = v + g[rr] * *(const f32x4*)(wa2 + (r4 * 4 + rr) * 256 + (n - C_Z)); } }
        else v = *(const f32x4*)(wr + n - 240);
        return v * nw[k]; };
    transpose_items(src, D, NPROJ, (bf16_t*)wptr(a, ws, l, WS_WIN), scr, gw, NGW, lane);
}
__device__ __forceinline__ void conv_w_gate(const Args& a, unsigned char* ws, LAS float* scr, int l, int gw, int NGW, int lane);
template <class F>
__device__ __forceinline__ void transpose_items_fp8(F src4, int K, int N, unsigned char* WT, LAS float* scr, int gw, int NGW, int lane) {
    const int nblk = N / 32, nitems = (K / 64) * nblk;
    const int r8 = lane >> 3, c4 = lane & 7;
    for (int it = gw; it < nitems; it += NGW) {
        const int kb = it / nblk, nb = it - kb * nblk, k0 = 64 * kb, n0 = 32 * nb;
        f32x4 v[8];
#pragma unroll
        for (int i = 0; i < 8; ++i) v[i] = src4(k0 + i * 8 + r8, n0 + c4 * 4);
#pragma unroll
        for (int i = 0; i < 8; ++i) { LAS float* d = scr + (i * 8 + r8) * 33 + c4 * 4; d[0] = v[i][0]; d[1] = v[i][1]; d[2] = v[i][2]; d[3] = v[i][3]; }
        LDS_WAIT();
        const int c = lane & 7;
#pragma unroll
        for (int j = 0; j < 4; ++j) { const int n = (lane >> 3) + 8 * j; const LAS float* sp = scr + (8 * c) * 33 + n;
            u32x2 o; o.x = pk4_fp8(sp[0 * 33], sp[1 * 33], sp[2 * 33], sp[3 * 33]); o.y = pk4_fp8(sp[4 * 33], sp[5 * 33], sp[6 * 33], sp[7 * 33]);
            *(u32x2*)(WT + (size_t)(n0 + n) * K + k0 + 8 * c) = o; }
        LDS_WAIT();
    }
}
__device__ __forceinline__ void conv_w_gate(const Args& a, unsigned char* ws, LAS float* scr, int l, int gw, int NGW, int lane) {
    const float* W = a.w_in + (size_t)l * D * NIN + 3856; const float* nw = a.norm1_w + l * D;
    auto src = [=](int k, int n) -> f32x4 { return *(const f32x4*)(W + (size_t)k * NIN + n) * (nw[k] * WG8_SCALE); };
    transpose_items_fp8(src, D, NGATE, wptr(a, ws, l, WS_WG), scr, gw, NGW, lane);
}
__device__ __forceinline__ void conv_w_br(const Args& a, unsigned char* ws, LAS float* scr, int l, int gw, int NGW, int lane) {
    for (int g = 0; g < 3; ++g) { const float* W = a.w_branch + ((size_t)l * 3 + g) * 512 * 1024;
        auto src = [=](int k, int n) -> f32x4 { return *(const f32x4*)(W + (size_t)k * 1024 + n); };
        transpose_items(src, 512, 1024, (bf16_t*)wptr(a, ws, l, WS_WBR) + (size_t)g * 1024 * 512, scr, gw, NGW, lane); }
}
__device__ __forceinline__ void conv_w_o(const Args& a, unsigned char* ws, LAS float* scr, int l, int gw, int NGW, int lane) {
    const float* W = a.w_o + (size_t)l * D * D;
    auto src = [=](int k, int n) -> f32x4 { return *(const f32x4*)(W + (size_t)k * D + n); };
    transpose_items(src, D, D, (bf16_t*)wptr(a, ws, l, WS_WO), scr, gw, NGW, lane);
}
__device__ __forceinline__ void conv_w_up(const Args& a, unsigned char* ws, LAS float* scr, int l, int gw, int NGW, int lane) {
    const float* W = a.w_up + (size_t)l * D * DFF; const float* nw = a.norm2_w + l * D;
    auto src = [=](int k, int n) -> f32x4 { return *(const f32x4*)(W + (size_t)k * DFF + n) * nw[k]; };
    transpose_items(src, D, DFF, (bf16_t*)wptr(a, ws, l, WS_WUP), scr, gw, NGW, lane);
}
__device__ __forceinline__ void conv_w_dn(const Args& a, unsigned char* ws, LAS float* scr, int l, int gw, int NGW, int lane) {
    const float* W = a.w_down + (size_t)l * DFF * D;
    auto src = [=](int k, int n) -> f32x4 { return *(const f32x4*)(W + (size_t)k * D + n); };
    transpose_items(src, DFF, D, (bf16_t*)wdn_ptr(ws, l), scr, gw, NGW, lane);
}
__device__ __forceinline__ float wave_sum(float v) {
#pragma unroll
    for (int o = 1; o < 64; o <<= 1) v += __shfl_xor(v, o);
    return v;
}

__device__ __forceinline__ void conv_phase(const Args& a, unsigned char* ws, int l, int gtid, int gsz) {
    const bf16_t* P = (const bf16_t*)(ws + WS_PROJ); bf16_t* Y = (bf16_t*)(ws + WS_Y);
    const float* cw = a.conv_w + l * 3 * 512; const float* cb = a.conv_b + l * 512;
    for (int id = gtid; id < (M / 16) * 64; id += gsz) {
        const int c = (id & 63) * 8, r0 = (id >> 6) * 16;
        float w0[8], w1[8], w2[8], bb[8], um1[8], um2[8];
#pragma unroll
        for (int j = 0; j < 8; ++j) { w0[j] = cw[c + j]; w1[j] = cw[512 + c + j]; w2[j] = cw[1024 + c + j]; bb[j] = cb[c + j]; um1[j] = 0.f; um2[j] = 0.f; }
        if ((r0 & (SEQ - 1)) != 0) {
            const u32x4 x1 = *(const u32x4*)(P + (size_t)(r0 - 1) * NPROJ + C_CX + c), c1 = *(const u32x4*)(P + (size_t)(r0 - 1) * NPROJ + C_CC + c);
            const u32x4 x2 = *(const u32x4*)(P + (size_t)(r0 - 2) * NPROJ + C_CX + c), c2 = *(const u32x4*)(P + (size_t)(r0 - 2) * NPROJ + C_CC + c);
#pragma unroll
            for (int j = 0; j < 4; ++j) { um1[2 * j] = bflo(x1[j]) * bflo(c1[j]); um1[2 * j + 1] = bfhi(x1[j]) * bfhi(c1[j]); um2[2 * j] = bflo(x2[j]) * bflo(c2[j]); um2[2 * j + 1] = bfhi(x2[j]) * bfhi(c2[j]); }
        }
#pragma unroll 4
        for (int i = 0; i < 16; ++i) { const size_t ro = (size_t)(r0 + i) * NPROJ + c;
            const u32x4 xv = *(const u32x4*)(P + ro + C_CX), bv = *(const u32x4*)(P + ro + C_CB), cv = *(const u32x4*)(P + ro + C_CC);
            float u[8], y[8];
#pragma unroll
            for (int j = 0; j < 4; ++j) { u[2 * j] = bflo(xv[j]) * bflo(cv[j]); u[2 * j + 1] = bfhi(xv[j]) * bfhi(cv[j]); }
#pragma unroll
            for (int j = 0; j < 4; ++j) {
                y[2 * j] = bflo(bv[j]) * (w0[2 * j] * um2[2 * j] + w1[2 * j] * um1[2 * j] + w2[2 * j] * u[2 * j] + bb[2 * j]);
                y[2 * j + 1] = bfhi(bv[j]) * (w0[2 * j + 1] * um2[2 * j + 1] + w1[2 * j + 1] * um1[2 * j + 1] + w2[2 * j + 1] * u[2 * j + 1] + bb[2 * j + 1]); }
            u32x4 o; o.x = cvt_pk_bf16(y[0], y[1]); o.y = cvt_pk_bf16(y[2], y[3]); o.z = cvt_pk_bf16(y[4], y[5]); o.w = cvt_pk_bf16(y[6], y[7]);
            *(u32x4*)(Y + (size_t)(r0 + i) * YW + c) = o;
#pragma unroll
            for (int j = 0; j < 8; ++j) { um2[j] = um1[j]; um1[j] = u[j]; }
        }
    }
}

constexpr int SW_KS = 0, SW_VT = 36864, SW_QS = SW_VT + 33792;
__device__ __forceinline__ void qk_row_norm_rope(float (&v)[16], const float (&nw16)[16], int part, float scale, int pos, bool dorope) {
    float ss = 0.f;
#pragma unroll
    for (int i = 0; i < 16; ++i) ss += v[i] * v[i];
    ss += __shfl_xor(ss, 1); ss += __shfl_xor(ss, 2);
    const float rs = rsqrtf(ss * (1.0f / 64.0f) + EPS) ;
#pragma unroll
    for (int i = 0; i < 16; ++i) v[i] = v[i] * rs * nw16[i];
    if (part == 0 && dorope) {
        const float p = (float)pos;
#pragma unroll
        for (int i = 0; i < 8; ++i) {
            const float invf = exp2f(-(float)i * 2.3664460711655217f);
            float rev = p * invf * 0.15915494309189535f; rev = rev - floorf(rev);
            const float sn = __builtin_amdgcn_sinf(rev), cs = __builtin_amdgcn_cosf(rev);
            const float x1 = v[i], x2 = v[i + 8];
            v[i] = x1 * cs - x2 * sn; v[i + 8] = x2 * cs + x1 * sn; }
    }
#pragma unroll
    for (int i = 0; i < 16; ++i) v[i] *= scale;
}
__device__ __forceinline__ void swa_phase(const Args& a, unsigned char* ws, LAS unsigned char* lds, int l, int bid, int G) {
    const bf16_t* P = (const bf16_t*)(ws + WS_PROJ); bf16_t* Y = (bf16_t*)(ws + WS_Y);
    int tid_ = threadIdx.x; asm volatile("" : "+v"(tid_));
    const int tid = tid_, lane = tid & 63, w = __builtin_amdgcn_readfirstlane(tid >> 6), fr = lane & 15, fq = lane >> 4;
    const float* qnw = a.q_norm_w + l * 64; const float* knw = a.k_norm_w + l * 64; const float* sinks = a.sinks + l * 8;
    LAS bf16_t* Ks = (LAS bf16_t*)(lds + SW_KS); LAS bf16_t* Vt = (LAS bf16_t*)(lds + SW_VT); LAS bf16_t* Qs = (LAS bf16_t*)(lds + SW_QS);
    float kw16[16], qw16[16];
#pragma unroll
    for (int i = 0; i < 16; ++i) { kw16[i] = knw[(tid & 3) * 16 + i]; qw16[i] = qnw[(tid & 3) * 16 + i]; }
    for (int task = bid; task < 512; task += G) {
        const int b = task >> 5, kvh = (task >> 4) & 1, qblk = task & 15;
        __syncthreads();
#pragma unroll
        for (int pass = 0; pass < 2; ++pass) {
            const int idx = pass * 512 + tid, key = idx >> 2, part = idx & 3, kpos = (qblk - 1) * 128 + key;
            float v[16]; int pos = 0;
            if (kpos >= 0) { const size_t ro = (size_t)(b * SEQ + kpos) * NPROJ + C_SK + kvh * 64 + part * 16;
                const u32x4 a0 = *(const u32x4*)(P + ro), a1 = *(const u32x4*)(P + ro + 8);
#pragma unroll
                for (int j = 0; j < 4; ++j) { v[2 * j] = bflo(a0[j]); v[2 * j + 1] = bfhi(a0[j]); v[8 + 2 * j] = bflo(a1[j]); v[8 + 2 * j + 1] = bfhi(a1[j]); }
                pos = a.pos[b * SEQ + kpos];
            } else {
#pragma unroll
                for (int i = 0; i < 16; ++i) v[i] = 0.f; }
            qk_row_norm_rope(v, kw16, part, 1.0f, pos, kpos >= 0);
            u32x4 o0, o1;
            o0.x = cvt_pk_bf16(v[0], v[1]); o0.y = cvt_pk_bf16(v[2], v[3]); o0.z = cvt_pk_bf16(v[4], v[5]); o0.w = cvt_pk_bf16(v[6], v[7]);
            o1.x = cvt_pk_bf16(v[8], v[9]); o1.y = cvt_pk_bf16(v[10], v[11]); o1.z = cvt_pk_bf16(v[12], v[13]); o1.w = cvt_pk_bf16(v[14], v[15]);
            *(LAS u32x4*)(Ks + key * 72 + part * 16) = o0; *(LAS u32x4*)(Ks + key * 72 + part * 16 + 8) = o1;
        }
#pragma unroll
        for (int pass = 0; pass < 4; ++pass) {
            const int idx = pass * 512 + tid, key = idx & 255, c8 = idx >> 8, kpos = (qblk - 1) * 128 + key;
            u32x4 vv = (u32x4){0u, 0u, 0u, 0u};
            if (kpos >= 0) vv = *(const u32x4*)(P + (size_t)(b * SEQ + kpos) * NPROJ + C_SV + kvh * 64 + c8 * 8);
#pragma unroll
            for (int j = 0; j < 4; ++j) { Vt[(c8 * 8 + 2 * j) * 264 + key] = (bf16_t)(vv[j] & 0xffffu); Vt[(c8 * 8 + 2 * j + 1) * 264 + key] = (bf16_t)(vv[j] >> 16); }
        }
        for (int g = 0; g < 4; ++g) {
            const int h = kvh * 4 + g;
            __syncthreads();
            {
                const int q = tid >> 2, part = tid & 3; const int t = qblk * 128 + q;
                const size_t ro = (size_t)(b * SEQ + t) * NPROJ + C_SQ + h * 64 + part * 16;
                const u32x4 a0 = *(const u32x4*)(P + ro), a1 = *(const u32x4*)(P + ro + 8);
                float v[16];
#pragma unroll
                for (int j = 0; j < 4; ++j) { v[2 * j] = bflo(a0[j]); v[2 * j + 1] = bfhi(a0[j]); v[8 + 2 * j] = bflo(a1[j]); v[8 + 2 * j + 1] = bfhi(a1[j]); }
                qk_row_norm_rope(v, qw16, part, 0.125f, a.pos[b * SEQ + t], true);
                u32x4 o0, o1;
                o0.x = cvt_pk_bf16(v[0], v[1]); o0.y = cvt_pk_bf16(v[2], v[3]); o0.z = cvt_pk_bf16(v[4], v[5]); o0.w = cvt_pk_bf16(v[6], v[7]);
                o1.x = cvt_pk_bf16(v[8], v[9]); o1.y = cvt_pk_bf16(v[10], v[11]); o1.z = cvt_pk_bf16(v[12], v[13]); o1.w = cvt_pk_bf16(v[14], v[15]);
                *(LAS u32x4*)(Qs + q * 72 + part * 16) = o0; *(LAS u32x4*)(Qs + q * 72 + part * 16 + 8) = o1;
            }
            __syncthreads();
            bf16x8 qf[2];
#pragma unroll
            for (int ks = 0; ks < 2; ++ks) qf[ks] = *(const LAS bf16x8*)(Qs + (16 * w + fr) * 72 + ks * 32 + fq * 8);
            f32x4 s[9];
#pragma unroll
            for (int tt = 0; tt < 9; ++tt) { s[tt] = (f32x4){0.f, 0.f, 0.f, 0.f};
#pragma unroll
                for (int ks = 0; ks < 2; ++ks) { const bf16x8 ka = *(const LAS bf16x8*)(Ks + ((w + tt) * 16 + fr) * 72 + ks * 32 + fq * 8);
                    s[tt] = __builtin_amdgcn_mfma_f32_16x16x32_bf16(ka, qf[ks], s[tt], 0, 0, 0); } }
            const float sink = sinks[h];
            const int qi = 16 * w + fr;
            float mx = -3.0e38f;
#pragma unroll
            for (int tt = 0; tt < 9; ++tt)
#pragma unroll
                for (int j = 0; j < 4; ++j) { const int c = (w + tt) * 16 + fq * 4 + j; const bool ok = (c > qi) && (c <= qi + 128) && (qblk > 0 || c >= 128);
                    s[tt][j] = ok ? s[tt][j] : -3.0e38f; mx = fmaxf(mx, s[tt][j]); }
            mx = fmaxf(mx, __shfl_xor(mx, 16)); mx = fmaxf(mx, __shfl_xor(mx, 32));
            const float mm = fmaxf(mx, sink);
            float sum = 0.f;
#pragma unroll
            for (int tt = 0; tt < 9; ++tt)
#pragma unroll
                for (int j = 0; j < 4; ++j) { const float p = (s[tt][j] > -1.0e38f) ? __expf(s[tt][j] - mm) : 0.f; s[tt][j] = p; sum += p; }
            sum += __shfl_xor(sum, 16); sum += __shfl_xor(sum, 32);
            const float inv = 1.0f / (sum + __expf(sink - mm));
            f32x4 o[4];
#pragma unroll
            for (int dt = 0; dt < 4; ++dt) o[dt] = (f32x4){0.f, 0.f, 0.f, 0.f};
#pragma unroll
            for (int kp = 0; kp < 5; ++kp) {
                const int t0 = 2 * kp, t1 = 2 * kp + 1;
                union { u32x4 u; bf16x8 h; } pb;
                pb.u.x = cvt_pk_bf16(s[t0][0], s[t0][1]); pb.u.y = cvt_pk_bf16(s[t0][2], s[t0][3]);
                if (t1 < 9) { pb.u.z = cvt_pk_bf16(s[t1 < 9 ? t1 : 0][0], s[t1 < 9 ? t1 : 0][1]); pb.u.w = cvt_pk_bf16(s[t1 < 9 ? t1 : 0][2], s[t1 < 9 ? t1 : 0][3]); } else { pb.u.z = 0u; pb.u.w = 0u; }
#pragma unroll
                for (int dt = 0; dt < 4; ++dt) {
                    union { u32x4 u; bf16x8 h; } va;
                    const u32x2 lo = *(const LAS u32x2*)(Vt + (dt * 16 + fr) * 264 + (w + t0) * 16 + fq * 4);
                    u32x2 hi = (u32x2){0u, 0u};
                    if (t1 < 9) hi = *(const LAS u32x2*)(Vt + (dt * 16 + fr) * 264 + (w + (t1 < 9 ? t1 : 0)) * 16 + fq * 4);
                    va.u.x = lo.x; va.u.y = lo.y; va.u.z = hi.x; va.u.w = hi.y;
                    o[dt] = __builtin_amdgcn_mfma_f32_16x16x32_bf16(va.h, pb.h, o[dt], 0, 0, 0); }
            }
            const size_t yo = (size_t)(b * SEQ + qblk * 128 + qi) * YW + 1024 + h * 64 + fq * 4;
#pragma unroll
            for (int dt = 0; dt < 4; ++dt) { u32x2 ov; ov.x = cvt_pk_bf16(o[dt][0] * inv, o[dt][1] * inv); ov.y = cvt_pk_bf16(o[dt][2] * inv, o[dt][3] * inv); *(u32x2*)(Y + yo + dt * 16) = ov; }
        }
    }
    __syncthreads();
}

constexpr int GL_KE = 0, GL_VT = 9216, GL_QS = GL_VT + 18432, GL_ST = GL_QS + 9216, GL_TOT = GL_ST + 18432, GL_RED = GL_TOT + 2048;
struct GlaRegs { unsigned short g[8], k[8], q[8], v[16]; u32x4 st[2]; u32x2 r[4]; f32x4 pc[2]; };
template <bool STEP3>
__device__ __forceinline__ void gla_load(GlaRegs& R, const bf16_t* P, const bf16_t* ST, const float* PC, int c, int seg, int d, int tid, int w, int fr, int fq) {
    const int bh = c >> 5, n = c & 31, b = bh >> 2, h = bh & 3, row0 = b * SEQ + n * 64;
#pragma unroll
    for (int i = 0; i < 8; ++i) { const size_t ro = (size_t)(row0 + seg * 8 + i) * NPROJ + h * 64 + d;
        R.g[i] = P[ro + C_Z]; R.k[i] = P[ro + C_GK]; if (STEP3) R.q[i] = P[ro + C_GQ]; }
#pragma unroll
    for (int half = 0; half < 2; ++half)
#pragma unroll
        for (int i = 0; i < 8; ++i) R.v[half * 8 + i] = P[(size_t)(row0 + seg * 8 + i) * NPROJ + C_GV + h * 128 + half * 64 + d];
    if (STEP3) {
#pragma unroll
        for (int j = 0; j < 2; ++j) { const int idx = j * 512 + tid, v = idx >> 3, c8 = idx & 7; R.st[j] = *(const u32x4*)(ST + ((size_t)c * 128 + v) * 64 + c8 * 8); }
        R.pc[0] = *(const f32x4*)(PC + (size_t)c * 64 + (tid & 7) * 8); R.pc[1] = *(const f32x4*)(PC + (size_t)c * 64 + (tid & 7) * 8 + 4);
        const int it = w >> 1, vh = w & 1, row = row0 + it * 16 + fr;
#pragma unroll
        for (int x = 0; x < 4; ++x) R.r[x] = *(const u32x2*)(P + (size_t)row * NPROJ + C_GR + h * 128 + (vh * 4 + x) * 16 + fq * 4);
    }
}
__device__ __forceinline__ void gla_cumsum(const GlaRegs& R, LAS float* tot, int seg, int d, float (&bv)[8], float& blast) {
#pragma unroll
    for (int i = 0; i < 8; ++i) bv[i] = bf2f(R.g[i]);
#pragma unroll
    for (int i = 1; i < 8; ++i) bv[i] += bv[i - 1];
    tot[seg * 64 + d] = bv[7];
    __syncthreads();
    float off = 0.f, all = 0.f;
#pragma unroll
    for (int s = 0; s < 8; ++s) { const float t = tot[s * 64 + d]; all += t; off += (s < seg) ? t : 0.f; }
#pragma unroll
    for (int i = 0; i < 8; ++i) bv[i] += off;
    blast = all;
}
__device__ __forceinline__ void gla_stage_v(const GlaRegs& R, LAS bf16_t* Vt, int seg, int d) {
#pragma unroll
    for (int half = 0; half < 2; ++half) { const int v = half * 64 + d; const unsigned short* e = R.v + half * 8;
        u32x4 o; o.x = e[0] | ((unsigned)e[1] << 16); o.y = e[2] | ((unsigned)e[3] << 16); o.z = e[4] | ((unsigned)e[5] << 16); o.w = e[6] | ((unsigned)e[7] << 16);
        *(LAS u32x4*)(Vt + v * 72 + seg * 8) = o; }
}
constexpr int GL_DECL = GL_RED + 512, GL_CS = 65536;
__device__ __forceinline__ void gla1_phase(const Args& a, unsigned char* ws, LAS unsigned char* lds, int bid, int G) {
    const bf16_t* P = (const bf16_t*)(ws + WS_PROJ); bf16_t* ST = (bf16_t*)(ws + WS_S);
    float* AGG = (float*)((unsigned char*)a.out + DO_AGG); float* PC = (float*)((unsigned char*)a.out + DO_PC); float* AGGD = (float*)((unsigned char*)a.out + DO_AGGD);
    int tid_ = threadIdx.x; asm volatile("" : "+v"(tid_));
    const int tid = tid_, lane = tid & 63, w = __builtin_amdgcn_readfirstlane(tid >> 6), fr = lane & 15, fq = lane >> 4, seg = tid >> 6, d = tid & 63;
    LAS bf16_t* KEt = (LAS bf16_t*)(lds + GL_KE); LAS bf16_t* Vt = (LAS bf16_t*)(lds + GL_VT); LAS float* tot = (LAS float*)(lds + GL_TOT); LAS float* declds = (LAS float*)(lds + GL_DECL);
    GlaRegs R;
    if (bid < 256) gla_load<false>(R, P, ST, PC, bid * 8, seg, d, tid, w, fr, fq);
    for (int r = bid; r < 256; r += G) {
        f32x4 sl[4];
#pragma unroll
        for (int dt = 0; dt < 4; ++dt) sl[dt] = (f32x4){0.f, 0.f, 0.f, 0.f};
        float prun = 1.0f;
        for (int i = 0; i < 8; ++i) {
            const int c = r * 8 + i;
            __syncthreads();
            float bv[8], blast; gla_cumsum(R, tot, seg, d, bv, blast);
            float ke[8];
#pragma unroll
            for (int e = 0; e < 8; ++e) ke[e] = bf2f(R.k[e]) * __expf(blast - bv[e]);
            u32x4 o; o.x = cvt_pk_bf16(ke[0], ke[1]); o.y = cvt_pk_bf16(ke[2], ke[3]); o.z = cvt_pk_bf16(ke[4], ke[5]); o.w = cvt_pk_bf16(ke[6], ke[7]);
            *(LAS u32x4*)(KEt + d * 72 + seg * 8) = o;
            if (seg == 0) { PC[(size_t)c * 64 + d] = prun; const float ed = __expf(blast); declds[d] = ed; prun *= ed; }
            gla_stage_v(R, Vt, seg, d);
            { const int cn = (i < 7) ? c + 1 : (r + G) * 8; if (cn < 2048) gla_load<false>(R, P, ST, PC, cn, seg, d, tid, w, fr, fq); }
            __syncthreads();
            f32x4 acc[4];
#pragma unroll
            for (int dt = 0; dt < 4; ++dt) acc[dt] = (f32x4){0.f, 0.f, 0.f, 0.f};
#pragma unroll
            for (int ks = 0; ks < 2; ++ks) { const bf16x8 vb = *(const LAS bf16x8*)(Vt + (w * 16 + fr) * 72 + ks * 32 + fq * 8);
#pragma unroll
                for (int dt = 0; dt < 4; ++dt) { const bf16x8 ka = *(const LAS bf16x8*)(KEt + (dt * 16 + fr) * 72 + ks * 32 + fq * 8);
                    acc[dt] = __builtin_amdgcn_mfma_f32_16x16x32_bf16(ka, vb, acc[dt], 0, 0, 0); } }
#pragma unroll
            for (int dt = 0; dt < 4; ++dt) { const f32x4 dv = *(const LAS f32x4*)(declds + dt * 16 + fq * 4);
                u32x2 ov; ov.x = cvt_pk_bf16(sl[dt][0], sl[dt][1]); ov.y = cvt_pk_bf16(sl[dt][2], sl[dt][3]);
                *(u32x2*)(ST + ((size_t)c * 128 + w * 16 + fr) * 64 + dt * 16 + fq * 4) = ov;
                sl[dt] = dv * sl[dt] + acc[dt]; }
        }
#pragma unroll
        for (int dt = 0; dt < 4; ++dt) *(f32x4*)(AGG + ((size_t)r * 128 + w * 16 + fr) * 64 + dt * 16 + fq * 4) = sl[dt];
        if (seg == 0) AGGD[r * 64 + d] = prun;
    }
    __syncthreads();
}
__device__ __forceinline__ void gla_scan_phase(unsigned char* ws, int gtid, int gsz) {
    bf16_t* ST = (bf16_t*)(ws + WS_S); const float* dec = (const float*)(ws + WS_DEC);
    for (int id = gtid; id < 65536; id += gsz) {
        const int dg = id & 7, v = (id >> 3) & 127, bh = id >> 10;
        float s[8];
#pragma unroll
        for (int i = 0; i < 8; ++i) s[i] = 0.f;
        for (int n0 = 0; n0 < 32; n0 += 8) {
            u32x4 kv[8]; f32x4 d0[8], d1[8];
#pragma unroll
            for (int j = 0; j < 8; ++j) { const int c = bh * 32 + n0 + j; kv[j] = *(const u32x4*)(ST + ((size_t)c * 128 + v) * 64 + dg * 8);
                d0[j] = *(const f32x4*)(dec + c * 64 + dg * 8); d1[j] = *(const f32x4*)(dec + c * 64 + dg * 8 + 4); }
#pragma unroll
            for (int j = 0; j < 8; ++j) { const int c = bh * 32 + n0 + j;
                u32x4 o; o.x = cvt_pk_bf16(s[0], s[1]); o.y = cvt_pk_bf16(s[2], s[3]); o.z = cvt_pk_bf16(s[4], s[5]); o.w = cvt_pk_bf16(s[6], s[7]);
                *(u32x4*)(ST + ((size_t)c * 128 + v) * 64 + dg * 8) = o;
                s[0] = d0[j][0] * s[0] + bflo(kv[j].x); s[1] = d0[j][1] * s[1] + bfhi(kv[j].x); s[2] = d0[j][2] * s[2] + bflo(kv[j].y); s[3] = d0[j][3] * s[3] + bfhi(kv[j].y);
                s[4] = d1[j][0] * s[4] + bflo(kv[j].z); s[5] = d1[j][1] * s[5] + bfhi(kv[j].z); s[6] = d1[j][2] * s[6] + bflo(kv[j].w); s[7] = d1[j][3] * s[7] + bfhi(kv[j].w); }
        }
    }
}
__device__ __forceinline__ void gla3_phase(const Args& a, unsigned char* ws, LAS unsigned char* lds, int l, int bid, int G) {
    const bf16_t* P = (const bf16_t*)(ws + WS_PROJ); const bf16_t* ST = (const bf16_t*)(ws + WS_S); bf16_t* Y = (bf16_t*)(ws + WS_Y);
    const float* AGG = (const float*)((const unsigned char*)a.out + DO_AGG); const float* PC = (const float*)((const unsigned char*)a.out + DO_PC); const float* AGGD = (const float*)((const unsigned char*)a.out + DO_AGGD);
    LAS float* Cs = (LAS float*)(lds + GL_CS);
    const float* onw = a.gla_onorm_w + l * 128;
    int tid_ = threadIdx.x; asm volatile("" : "+v"(tid_));
    const int tid = tid_, lane = tid & 63, w = __builtin_amdgcn_readfirstlane(tid >> 6), fr = lane & 15, fq = lane >> 4, seg = tid >> 6, d = tid & 63;
    LAS bf16_t* Ks = (LAS bf16_t*)(lds + GL_KE); LAS bf16_t* Vt = (LAS bf16_t*)(lds + GL_VT); LAS bf16_t* Qs = (LAS bf16_t*)(lds + GL_QS); LAS bf16_t* STs = (LAS bf16_t*)(lds + GL_ST);
    LAS float* tot = (LAS float*)(lds + GL_TOT); LAS float* red = (LAS float*)(lds + GL_RED);
    const int it = w >> 1, vh = w & 1;
    f32x4 onw4[4];
#pragma unroll
    for (int x = 0; x < 4; ++x) onw4[x] = *(const f32x4*)(onw + (vh * 4 + x) * 16 + fq * 4);
    GlaRegs R;
    if (bid < 256) gla_load<true>(R, P, ST, PC, bid * 8, seg, d, tid, w, fr, fq);
    for (int r = bid; r < 256; r += G) {
      {
        __syncthreads();
        const int q = r & 3, r0 = r & ~3, cv = tid >> 2, cd0 = (tid & 3) * 16;
        f32x4 C[4];
#pragma unroll
        for (int k = 0; k < 4; ++k) C[k] = (f32x4){0.f, 0.f, 0.f, 0.f};
        f32x4 Kk[3][4], Dd[3][4];
#pragma unroll
        for (int qq = 0; qq < 3; ++qq) { const int rr = r0 + (qq < q ? qq : 0);
#pragma unroll
            for (int k = 0; k < 4; ++k) { Kk[qq][k] = *(const f32x4*)(AGG + ((size_t)rr * 128 + cv) * 64 + cd0 + 4 * k); Dd[qq][k] = *(const f32x4*)(AGGD + rr * 64 + cd0 + 4 * k); } }
#pragma unroll
        for (int qq = 0; qq < 3; ++qq)
#pragma unroll
            for (int k = 0; k < 4; ++k) { const bool on = qq < q; C[k] = (on ? Dd[qq][k] : (f32x4){1.f, 1.f, 1.f, 1.f}) * C[k] + (on ? Kk[qq][k] : (f32x4){0.f, 0.f, 0.f, 0.f}); }
#pragma unroll
        for (int k = 0; k < 4; ++k) *(LAS f32x4*)(Cs + cv * 64 + cd0 + 4 * k) = C[k];
      }
      for (int ci = 0; ci < 8; ++ci) { const int c = r * 8 + ci;
        const int bh = c >> 5, n = c & 31, b = bh >> 2, h = bh & 3, row0 = b * SEQ + n * 64;
        __syncthreads();
        float bv[8], blast; gla_cumsum(R, tot, seg, d, bv, blast);
#pragma unroll
        for (int i = 0; i < 8; ++i) {
            const float qv = bf2f(R.q[i]) * 0.125f * __expf(bv[i]), kv = bf2f(R.k[i]) * __expf(-bv[i]);
            const unsigned pk = cvt_pk_bf16(qv, kv);
            Qs[(seg * 8 + i) * 72 + d] = (bf16_t)(pk & 0xffffu); Ks[(seg * 8 + i) * 72 + d] = (bf16_t)(pk >> 16); }
        gla_stage_v(R, Vt, seg, d);
#pragma unroll
        for (int j = 0; j < 2; ++j) { const int idx = j * 512 + tid, v = idx >> 3, c8 = idx & 7; const u32x4 st = R.st[j];
            const f32x4 c0 = *(const LAS f32x4*)(Cs + v * 64 + c8 * 8), c1 = *(const LAS f32x4*)(Cs + v * 64 + c8 * 8 + 4);
            u32x4 o; o.x = cvt_pk_bf16(bflo(st.x) + R.pc[0][0] * c0[0], bfhi(st.x) + R.pc[0][1] * c0[1]); o.y = cvt_pk_bf16(bflo(st.y) + R.pc[0][2] * c0[2], bfhi(st.y) + R.pc[0][3] * c0[3]);
            o.z = cvt_pk_bf16(bflo(st.z) + R.pc[1][0] * c1[0], bfhi(st.z) + R.pc[1][1] * c1[1]); o.w = cvt_pk_bf16(bflo(st.w) + R.pc[1][2] * c1[2], bfhi(st.w) + R.pc[1][3] * c1[3]);
            *(LAS u32x4*)(STs + v * 72 + c8 * 8) = o; }
        u32x2 rw[4];
#pragma unroll
        for (int x = 0; x < 4; ++x) rw[x] = R.r[x];
        { const int cn = (ci < 7) ? c + 1 : (r + G) * 8; if (cn < 2048) gla_load<true>(R, P, ST, PC, cn, seg, d, tid, w, fr, fq); }
        __syncthreads();
        bf16x8 bq[2];
#pragma unroll
        for (int ks = 0; ks < 2; ++ks) bq[ks] = *(const LAS bf16x8*)(Qs + (it * 16 + fr) * 72 + ks * 32 + fq * 8);
        f32x4 at[4];
#pragma unroll
        for (int jt = 0; jt < 4; ++jt) { at[jt] = (f32x4){0.f, 0.f, 0.f, 0.f};
#pragma unroll
            for (int ks = 0; ks < 2; ++ks) { const bf16x8 ka = *(const LAS bf16x8*)(Ks + (jt * 16 + fr) * 72 + ks * 32 + fq * 8);
                at[jt] = __builtin_amdgcn_mfma_f32_16x16x32_bf16(ka, bq[ks], at[jt], 0, 0, 0); }
#pragma unroll
            for (int jj = 0; jj < 4; ++jj) { const int j = jt * 16 + fq * 4 + jj, i = it * 16 + fr; at[jt][jj] = (j <= i) ? at[jt][jj] : 0.f; } }
        union { u32x4 u; bf16x8 h; } bp[2];
#pragma unroll
        for (int kp = 0; kp < 2; ++kp) { bp[kp].u.x = cvt_pk_bf16(at[2 * kp][0], at[2 * kp][1]); bp[kp].u.y = cvt_pk_bf16(at[2 * kp][2], at[2 * kp][3]);
            bp[kp].u.z = cvt_pk_bf16(at[2 * kp + 1][0], at[2 * kp + 1][1]); bp[kp].u.w = cvt_pk_bf16(at[2 * kp + 1][2], at[2 * kp + 1][3]); }
        f32x4 o[4]; float ssq = 0.f;
#pragma unroll
        for (int x = 0; x < 4; ++x) { const int vt = vh * 4 + x; o[x] = (f32x4){0.f, 0.f, 0.f, 0.f};
#pragma unroll
            for (int kp = 0; kp < 2; ++kp) { union { u32x4 u; bf16x8 h; } va;
                const u32x2 lo = *(const LAS u32x2*)(Vt + (vt * 16 + fr) * 72 + (2 * kp) * 16 + fq * 4), hi = *(const LAS u32x2*)(Vt + (vt * 16 + fr) * 72 + (2 * kp + 1) * 16 + fq * 4);
                va.u.x = lo.x; va.u.y = lo.y; va.u.z = hi.x; va.u.w = hi.y;
                o[x] = __builtin_amdgcn_mfma_f32_16x16x32_bf16(va.h, bp[kp].h, o[x], 0, 0, 0); }
#pragma unroll
            for (int ks = 0; ks < 2; ++ks) { const bf16x8 sa = *(const LAS bf16x8*)(STs + (vt * 16 + fr) * 72 + ks * 32 + fq * 8);
                o[x] = __builtin_amdgcn_mfma_f32_16x16x32_bf16(sa, bq[ks], o[x], 0, 0, 0); }
            ssq += (o[x][0] * o[x][0] + o[x][1] * o[x][1]) + (o[x][2] * o[x][2] + o[x][3] * o[x][3]); }
        ssq += __shfl_xor(ssq, 16); ssq += __shfl_xor(ssq, 32);
        if (fq == 0) red[(it * 16 + fr) * 2 + vh] = ssq;
        __syncthreads();
        const float rstd = rsqrtf((red[(it * 16 + fr) * 2] + red[(it * 16 + fr) * 2 + 1]) * (1.0f / 128.0f) + EPS);
        const int row = row0 + it * 16 + fr;
#pragma unroll
        for (int x = 0; x < 4; ++x) { const int vcol = (vh * 4 + x) * 16 + fq * 4;
            const f32x4 ow = onw4[x];
            const float r0 = bflo(rw[x].x), r1 = bfhi(rw[x].x), r2 = bflo(rw[x].y), r3 = bfhi(rw[x].y);
            const float y0 = o[x][0] * rstd * ow[0] * r0 * fsigmoid(r0), y1 = o[x][1] * rstd * ow[1] * r1 * fsigmoid(r1);
            const float y2 = o[x][2] * rstd * ow[2] * r2 * fsigmoid(r2), y3 = o[x][3] * rstd * ow[3] * r3 * fsigmoid(r3);
            u32x2 ov; ov.x = cvt_pk_bf16(y0, y1); ov.y = cvt_pk_bf16(y2, y3);
            *(u32x2*)(Y + (size_t)row * YW + 512 + h * 128 + vcol) = ov; }
      }
    }
    __syncthreads();
}

#define RLX_AGENT __ATOMIC_RELAXED, __HIP_MEMORY_SCOPE_AGENT
constexpr size_t WS_BAR = 3 * MiB;
constexpr int MISC_OFF = 131072 + 320;
#define XB_TMO      128
#define XB_XCNT(j)  (256  + 64 * (j))
#define XB_XSUB(j)  (1280 + 64 * (j))
#define XB_XGEN(j)  (2304 + 64 * (j))
#define XB_TOP      3328
#define XB_TOPGEN   3392
#define XCD_BAR_WORDS 3456
#define XB_SPIN_CAP (1u << 18)

__device__ __forceinline__ unsigned xb_ld(unsigned* p)              { return __hip_atomic_load(p, __ATOMIC_RELAXED, __HIP_MEMORY_SCOPE_AGENT); }
__device__ __forceinline__ unsigned xb_add(unsigned* p, unsigned v) { return __hip_atomic_fetch_add(p, v, __ATOMIC_RELAXED, __HIP_MEMORY_SCOPE_AGENT); }
__device__ __forceinline__ unsigned xb_xcc_id() { return (unsigned)__builtin_amdgcn_s_getreg((3 << 11) | 20) & 0xFu; }
#define XB_SPIN(cond, bar) do { unsigned _sp = 0; while (cond) { __builtin_amdgcn_s_sleep(1); \
    if ((++_sp & 255u) == 0u) { if (xb_ld(&(bar)[XB_TMO])) break; if (_sp > XB_SPIN_CAP) { atomicAdd(&(bar)[XB_TMO], 1u); break; } } } } while (0)

struct XcdBarrier {
    unsigned* bar; unsigned x;
    volatile LAS unsigned* st;
};

__device__ __forceinline__ XcdBarrier xcd_barrier_post(unsigned* bar, volatile LAS unsigned* st) {
    XcdBarrier b; b.bar = bar; b.x = xb_xcc_id(); b.st = st;
    if (threadIdx.x == 0) (void)xb_add(&bar[XB_XCNT(b.x)], 1u);
    return b;
}
__device__ __forceinline__ void xcd_barrier_complete(unsigned* bar, unsigned x, unsigned& nloc, unsigned& nx) {
    const unsigned G = gridDim.x * gridDim.y * gridDim.z;
    unsigned sum, cnt, mine, sp = 0u;
    for (;;) {
        sum = 0u; cnt = 0u; mine = 0u;
#pragma unroll
        for (unsigned j = 0; j < 16; ++j) { const unsigned c = xb_ld(&bar[XB_XCNT(j)]); sum += c; cnt += (c > 0u) ? 1u : 0u; mine = (j == x) ? c : mine; }
        if (sum == G) break;
        __builtin_amdgcn_s_sleep(1);
        if ((++sp & 255u) == 0u) { if (xb_ld(&bar[XB_TMO])) break; if (sp > XB_SPIN_CAP) { atomicAdd(&bar[XB_TMO], 1u); break; } }
    }
    nloc = mine > 0u ? mine : 1u; nx = cnt > 0u ? cnt : 1u;
}

__device__ __forceinline__ void xcd_barrier(const XcdBarrier& b) {
    asm volatile("s_waitcnt vmcnt(0)" ::: "memory");
    __syncthreads();
    if (threadIdx.x == 0) {
        unsigned* bar = b.bar;
        __builtin_amdgcn_s_waitcnt(0);
        unsigned nloc = b.st[0], nx = b.st[1];
        if (nloc == 0u) { xcd_barrier_complete(bar, b.x, nloc, nx); b.st[0] = nloc; b.st[1] = nx; }
        const unsigned old = xb_add(&bar[XB_XSUB(b.x)], 1u);
        const unsigned gen = old / nloc;
        if (old + 1u == (gen + 1u) * nloc) {
            __builtin_amdgcn_fence(__ATOMIC_RELEASE, "agent");
            asm volatile("s_waitcnt vmcnt(0)" ::: "memory");
            const unsigned og = xb_add(&bar[XB_TOP], 1u);
            const unsigned tg = og / nx;
            if (og + 1u == (tg + 1u) * nx) xb_add(&bar[XB_TOPGEN], 1u);
            else XB_SPIN(xb_ld(&bar[XB_TOPGEN]) == tg, bar);
            __builtin_amdgcn_fence(__ATOMIC_ACQUIRE, "agent");
            xb_add(&bar[XB_XGEN(b.x)], 1u);
            asm volatile("s_waitcnt vmcnt(0)" ::: "memory");
        } else {
            XB_SPIN(xb_ld(&bar[XB_XGEN(b.x)]) == gen, bar);
            __builtin_amdgcn_fence(__ATOMIC_ACQUIRE, "agent");
            asm volatile("s_waitcnt vmcnt(0)" ::: "memory");
        }
    }
    __syncthreads();
}


typedef const __attribute__((address_space(4))) Args* ArgsPtr;
#define CG_SYNC() do { asm volatile("s_waitcnt vmcnt(0) lgkmcnt(0)" ::: "memory"); grid.sync(); __builtin_amdgcn_fence(__ATOMIC_ACQUIRE, "agent"); asm volatile("s_waitcnt vmcnt(0)" ::: "memory"); } while (0)
#define GRID_SYNC() do { ArgsPtr ap_ = (ArgsPtr)__builtin_amdgcn_kernarg_segment_ptr(); asm volatile("" : "+s"(ap_)); XcdBarrier xb_; xb_.bar = (unsigned*)(ap_->ws + WS_BAR); xb_.x = xb_xcc_id(); \
    xb_.st = (volatile LAS unsigned*)(lds + MISC_OFF) + 8; xcd_barrier(xb_); } while (0)
#define PH_BEGIN ArgsPtr ap = (ArgsPtr)__builtin_amdgcn_kernarg_segment_ptr(); int bid = blockIdx.x, G = gridDim.x; asm volatile("" : "+s"(ap), "+s"(bid), "+s"(G)); \
    const Args a = *ap; unsigned char* ws = a.ws; int tid = threadIdx.x; asm volatile("" : "+v"(tid)); const int lane = tid & 63, wave = __builtin_amdgcn_readfirstlane(tid >> 6); \
    const int gw = bid * 8 + wave, NGW = G * 8, gtid = bid * 512 + tid, gsz = G * 512; LAS float* scr = (LAS float*)(lds + wave * 16384); \
    (void)lane; (void)gw; (void)NGW; (void)gtid; (void)gsz; (void)scr; (void)ws;
__global__ void __launch_bounds__(512, 2) fwd_megakernel(Args a_unused) {
#if defined(__HIP_DEVICE_COMPILE__)
    extern __shared__ __attribute__((aligned(16))) unsigned char lds_raw[];
    cg::grid_group grid = cg::this_grid();
    LAS unsigned char* lds = (LAS unsigned char*)lds_raw;
    for (int u = threadIdx.x; u < (LDS_BYTES - 131072) / 4; u += 512) ((LAS unsigned*)(lds + 131072))[u] = 0u;
    __syncthreads();
    { ArgsPtr ap_ = (ArgsPtr)__builtin_amdgcn_kernarg_segment_ptr();
      if (blockIdx.x == 0) { unsigned* bw = (unsigned*)(ap_->ws + WS_BAR); for (int u = threadIdx.x; u < XCD_BAR_WORDS; u += 512) bw[u] = 0u; } }

    { PH_BEGIN
      for (int wl = 0; wl < 2; ++wl) { conv_w_in_main(a, ws, scr, wl, gw, NGW, lane); conv_w_gate(a, ws, scr, wl, gw, NGW, lane); conv_w_br(a, ws, scr, wl, gw, NGW, lane);
        conv_w_o(a, ws, scr, wl, gw, NGW, lane); conv_w_up(a, ws, scr, wl, gw, NGW, lane); conv_w_dn(a, ws, scr, wl, gw, NGW, lane); }
      bf16_t* XB = (bf16_t*)(ws + WS_XB); float* ssA = (float*)(ws + WS_SSA); float* ssB = (float*)(ws + WS_SSB);
      for (int m = gw; m < M; m += NGW) {
        const f32x4* xr = (const f32x4*)(a.x + (size_t)m * D) + lane; f32x4 v[4]; float s = 0.f;
#pragma unroll
        for (int j = 0; j < 4; ++j) { v[j] = xr[64 * j]; s += (v[j][0] * v[j][0] + v[j][1] * v[j][1]) + (v[j][2] * v[j][2] + v[j][3] * v[j][3]); }
        s = wave_sum(s);
        u32x2* o8 = (u32x2*)(XB + (size_t)m * D) + lane;
#pragma unroll
        for (int j = 0; j < 4; ++j) { u32x2 o; o.x = cvt_pk_bf16(v[j][0], v[j][1]); o.y = cvt_pk_bf16(v[j][2], v[j][3]); o8[64 * j] = o; }
        { unsigned* o4 = (unsigned*)((unsigned char*)a.out + (size_t)m * D) + lane;
#pragma unroll
          for (int j = 0; j < 4; ++j) o4[64 * j] = pk4_fp8(v[j][0], v[j][1], v[j][2], v[j][3]); }
        if (lane == 0) { ssA[m] = s; ssB[m] = 0.f; }
      }
    }
    CG_SYNC();
    { ArgsPtr ap_ = (ArgsPtr)__builtin_amdgcn_kernarg_segment_ptr(); (void)xcd_barrier_post((unsigned*)(ap_->ws + WS_BAR), (volatile LAS unsigned*)(lds + MISC_OFF) + 8); }

#pragma nounroll
    for (int l = 0; l < 2; ++l) {
        { PH_BEGIN
          pg8::Gemm g{(const bf16_t*)(ws + WS_XB), (const bf16_t*)wptr(a, ws, l, WS_WIN), D, D, D}; pg8::StaticOrder S; S.init(M, NPROJ, G, bid);
          pg8::EpiProj E{(bf16_t*)(ws + WS_PROJ), (const float*)(ws + WS_SSA), a.gla_ba + l * 256};
          pg8::gemm_phase<pg8::EpiProj, pg8::StaticOrder>(lds, g, S, E); }
        GRID_SYNC();
        { PH_BEGIN
          conv_phase(a, ws, l, gtid, gsz); }
        { PH_BEGIN
          swa_phase(a, ws, lds, l, bid, G); }
        { PH_BEGIN
          gla1_phase(a, ws, lds, bid, G); }
        GRID_SYNC();
        { PH_BEGIN
          gla3_phase(a, ws, lds, l, bid, G); }
        GRID_SYNC();
        { PH_BEGIN
          pg8::Gemm g{(const bf16_t*)a.out, (const bf16_t*)wptr(a, ws, l, WS_WG), D / 2, D / 2, D / 2}; pg8::GateOrder S; S.init(M, G, bid);
          pg8::EpiGate E{(bf16_t*)(ws + WS_PROJ), (const float*)(ws + WS_SSA), 1.0f / WG8_SCALE};
          pg8::gemm_phase<pg8::EpiGate, pg8::GateOrder, true>(lds, g, S, E); }
        { PH_BEGIN
          pg8::Gemm g{(const bf16_t*)(ws + WS_Y), (const bf16_t*)wptr(a, ws, l, WS_WBR), YW, 512, 512}; pg8::BrOrder S; S.init(M, G, bid);
          pg8::EpiBr E{(const bf16_t*)(ws + WS_PROJ), (bf16_t*)(ws + WS_MIXED)};
          pg8::gemm_phase<pg8::EpiBr, pg8::BrOrder>(lds, g, S, E); }
        GRID_SYNC();
        { PH_BEGIN
          { float* z = (float*)(ws + WS_SSA); for (int i = gtid; i < M; i += gsz) z[i] = 0.f; }
          pg8::Gemm g{(const bf16_t*)(ws + WS_MIXED), (const bf16_t*)wptr(a, ws, l, WS_WO), D, D, D}; pg8::StaticOrder S; S.init(M, D, G, bid);
          pg8::EpiRes E{(float*)nullptr, (bf16_t*)(ws + WS_XB), (float*)(ws + WS_SSB), (unsigned char*)nullptr};
          pg8::gemm_phase<pg8::EpiRes, pg8::StaticOrder>(lds, g, S, E); }
        GRID_SYNC();
        { PH_BEGIN
          pg8::Gemm g{(const bf16_t*)(ws + WS_XB), (const bf16_t*)wptr(a, ws, l, WS_WUP), D, D, D}; pg8::StaticOrder S; S.init(M, DFF, G, bid);
          pg8::EpiUp E{(bf16_t*)(ws + WS_PROJ), (const float*)(ws + WS_SSB)};
          pg8::gemm_phase<pg8::EpiUp, pg8::StaticOrder>(lds, g, S, E); }
        GRID_SYNC();
        { PH_BEGIN
          { float* z = (float*)(ws + WS_SSB); for (int i = gtid; i < M; i += gsz) z[i] = 0.f; }
          pg8::Gemm g{(const bf16_t*)(ws + WS_PROJ), (const bf16_t*)wdn_ptr(ws, l), DFF, DFF, DFF}; pg8::StaticOrder S; S.init(M, D, G, bid);
          pg8::EpiRes E{l == 1 ? a.out : (float*)nullptr, (bf16_t*)(ws + WS_XB), (float*)(ws + WS_SSA), l == 0 ? (unsigned char*)a.out : (unsigned char*)nullptr};
          pg8::gemm_phase<pg8::EpiRes, pg8::StaticOrder>(lds, g, S, E); }
        if (l == 0) GRID_SYNC();
    }
#endif
}

extern "C" void kernel_launch(void* const* d_in, const int* in_sizes, int n_in, void* d_out, int out_size, void* d_ws, size_t ws_size, hipStream_t stream) {
    static int grid = 0;
    if (grid == 0) {
        int dev = 0, cus = 0, per_cu = 0;
        if (hipGetDevice(&dev) != hipSuccess || hipDeviceGetAttribute(&cus, hipDeviceAttributeMultiprocessorCount, dev) != hipSuccess) { grid = -1; return; }
        if (hipFuncSetAttribute((const void*)fwd_megakernel, hipFuncAttributeMaxDynamicSharedMemorySize, LDS_BYTES) != hipSuccess) { fprintf(stderr, "hipFuncSetAttribute failed\n"); grid = -1; return; }
        if (hipOccupancyMaxActiveBlocksPerMultiprocessor(&per_cu, (const void*)fwd_megakernel, 512, LDS_BYTES) != hipSuccess || per_cu < 1) { fprintf(stderr, "occupancy query: %d\n", per_cu); per_cu = 1; }
        (void)hipGetLastError();
        if (per_cu > 1) per_cu = 1;
        grid = cus * per_cu;
        if (ws_size < WS_END) { fprintf(stderr, "workspace too small: %zu < %zu\n", ws_size, (size_t)WS_END); grid = -1; return; }
    }
    if (grid < 0) return;
    Args a{};
    a.x = (const float*)d_in[0]; a.pos = (const int*)d_in[1]; a.norm1_w = (const float*)d_in[2]; a.w_in = (const float*)d_in[3]; a.conv_w = (const float*)d_in[4]; a.conv_b = (const float*)d_in[5];
    a.gla_wa2 = (const float*)d_in[6]; a.gla_ba = (const float*)d_in[7]; a.gla_onorm_w = (const float*)d_in[8]; a.q_norm_w = (const float*)d_in[9]; a.k_norm_w = (const float*)d_in[10]; a.sinks = (const float*)d_in[11];
    a.w_branch = (const float*)d_in[12]; a.w_o = (const float*)d_in[13]; a.norm2_w = (const float*)d_in[14]; a.w_up = (const float*)d_in[15]; a.w_down = (const float*)d_in[16];
    a.out = (float*)d_out; a.ws = (unsigned char*)d_ws;
    void* args[] = {&a};
    hipError_t e = hipLaunchCooperativeKernel((const void*)fwd_megakernel, dim3(grid), dim3(512), args, LDS_BYTES, stream);
    if (e != hipSuccess) fprintf(stderr, "cooperative launch failed: %s (grid %d)\n", hipGetErrorString(e), grid);
}
```

```cpp
#include <hip/hip_runtime.h>
#include <hip/hip_cooperative_groups.h>
#include <cstdio>
#include <cstdint>
namespace cg = cooperative_groups;

#define LAS __attribute__((address_space(3)))
typedef unsigned short bf16_t;
typedef short bf16x8 __attribute__((ext_vector_type(8)));
typedef float f32x4 __attribute__((ext_vector_type(4)));
typedef unsigned u32x4 __attribute__((ext_vector_type(4)));
typedef unsigned u32x2 __attribute__((ext_vector_type(2)));
typedef int i32x4 __attribute__((ext_vector_type(4)));
typedef int i32x8 __attribute__((ext_vector_type(8)));

constexpr int M = 32768, SEQ = 2048, D = 1024, NPROJ = 4096, NGATE = 3072, DFF = 4096, NIN = 6928, YW = 1536;
constexpr float EPS = 1e-6f;
constexpr int C_CX = 0, C_CB = 512, C_CC = 1024, C_GQ = 1536, C_GK = 1792, C_GV = 2048, C_GR = 2560, C_Z = 3072, C_SQ = 3328, C_SK = 3840, C_SV = 3968;
constexpr size_t MiB = 1u << 20;
constexpr size_t WS_SSA = 0, WS_SSB = 1 * MiB, WS_DEC = 2 * MiB, WS_WIN = 4 * MiB, WS_WG = 12 * MiB, WS_WBR = 18 * MiB, WS_WO = 21 * MiB, WS_WUP = 23 * MiB, WS_WDN = 31 * MiB;
constexpr size_t WS_XB = 40 * MiB, WS_Y = 104 * MiB, WS_S = 200 * MiB, WS_PROJ = 232 * MiB, WS_MIXED = WS_PROJ + 192 * MiB, WS_END = 496 * MiB;
constexpr int LDS_BYTES = 147456;
constexpr size_t DO_W1 = 32 * MiB, DO_AGG = 68 * MiB, DO_PC = 76 * MiB, DO_AGGD = 77 * MiB, WS_WDN1 = 488 * MiB;

typedef float f32x2_t __attribute__((ext_vector_type(2))); typedef __bf16 bf16x2_t __attribute__((ext_vector_type(2)));
__device__ __forceinline__ unsigned cvt_pk_bf16(float lo, float hi) { f32x2_t v = {lo, hi}; bf16x2_t b = __builtin_convertvector(v, bf16x2_t); return __builtin_bit_cast(unsigned, b); }
__device__ __forceinline__ float bf2f(unsigned short h) { return __uint_as_float((unsigned)h << 16); }
__device__ __forceinline__ float bflo(unsigned w) { return __uint_as_float(w << 16); }
__device__ __forceinline__ float bfhi(unsigned w) { return __uint_as_float(w & 0xffff0000u); }
__device__ __forceinline__ float fsigmoid(float v) { return __builtin_amdgcn_rcpf(1.f + __expf(-v)); }
__device__ __forceinline__ float glog_of(float z) { return (fminf(z, 0.f) - __logf(1.f + __expf(-fabsf(z)))) * 0.0625f; }
#define LDS_WAIT() asm volatile("s_waitcnt lgkmcnt(0)" ::: "memory")
__device__ __forceinline__ unsigned pk4_fp8(float a, float b, float c, float d) { int w = __builtin_amdgcn_cvt_pk_fp8_f32(a, b, 0, false); w = __builtin_amdgcn_cvt_pk_fp8_f32(c, d, w, true); return (unsigned)w; }
constexpr float WG8_SCALE = 64.0f;

namespace pg8 {
constexpr int BM = 256, BK = 64, HALF = 128, HTB = HALF * BK * 2, NXCD = 8, WGM = 8;
__host__ __device__ __forceinline__ int lds_byte(int r, int c) { const int st = (r >> 4) * 2 + (c >> 5), rr = r & 15, cc = c & 31, ob = rr * 64 + cc * 2; return st * 1024 + (ob ^ (((ob >> 9) & 1) << 5)); }
__host__ __device__ __forceinline__ void stage_rc(int b, int& R, int& C) { const int st = b / 1024, sb = b % 1024, swz = sb ^ (((sb >> 9) & 1) << 5); R = (st >> 1) * 16 + swz / 64; C = (st & 1) * 32 + (swz % 64) / 2; }
__host__ __device__ __forceinline__ int perm32(int rho) { const int n = rho >> 4, i = rho & 15; return 8 * (i >> 2) + 4 * n + (i & 3); }
struct Unit { int pm, pn; };
struct Gemm { const bf16_t* A; const bf16_t* Bt; int lda, ldb, K; };
struct StaticOrder {
    int nM, nN, nwg, G, c;
    __device__ void init(int Mr, int N, int G_, int c_) { nM = Mr / BM; nN = N / BM; nwg = nM * nN; G = G_; c = c_; }
    __device__ bool next(int i, Unit& u) const {
        const long L = (long)i * G + c; if (L >= nwg) return false;
        int wgid = (int)L; { const int q = nwg / NXCD, r = nwg % NXCD, xcd = wgid % NXCD, off = wgid / NXCD; wgid = (xcd < r ? xcd * (q + 1) : r * (q + 1) + (xcd - r) * q) + off; }
        const int nig = WGM * nN, gid = wgid / nig, fm = gid * WGM, gsz = (nM - fm) < WGM ? (nM - fm) : WGM;
        u.pm = fm + ((wgid % nig) % gsz); u.pn = (wgid % nig) / gsz; return true;
    }
    __device__ __forceinline__ void ptrs(const Gemm& g, const Unit& u, const char*& cA, const char*& cB) const {
        cA = (const char*)g.A + (size_t)u.pm * BM * g.lda * 2; cB = (const char*)g.Bt + (size_t)u.pn * BM * g.ldb * 2; }
};
struct BrOrder {
    StaticOrder base;
    __device__ void init(int Mr, int G_, int c_) { base.init(Mr, 1024, G_, c_); }
    __device__ bool next(int i, Unit& u) const { Unit b; const int ib = i / 3, g = i - ib * 3; if (!base.next(ib, b)) return false; u.pm = b.pm; u.pn = g * 4 + b.pn; return true; }
    __device__ __forceinline__ void ptrs(const Gemm& g, const Unit& u, const char*& cA, const char*& cB) const {
        cA = (const char*)g.A + (size_t)u.pm * BM * g.lda * 2 + (size_t)(u.pn >> 2) * 512 * 2; cB = (const char*)g.Bt + (size_t)u.pn * BM * g.ldb * 2; }
};

struct GateOrder {
    StaticOrder base;
    __device__ void init(int Mr, int G_, int c_) { base.init(Mr, 1024, G_, c_); }
    __device__ bool next(int i, Unit& u) const { Unit b; const int ib = i / 3, g = i - ib * 3; if (!base.next(ib, b)) return false; u.pm = b.pm; u.pn = g * 4 + b.pn; return true; }
    __device__ __forceinline__ void ptrs(const Gemm& g, const Unit& u, const char*& cA, const char*& cB) const {
        cA = (const char*)g.A + (size_t)u.pm * BM * g.lda * 2; cB = (const char*)g.Bt + (size_t)u.pn * BM * g.ldb * 2; }
};
template <class Epi, class Sched, bool FP8 = false>
__device__ __forceinline__ void gemm_phase(LAS unsigned char* lds, const Gemm g, const Sched& S, const Epi& E) {
    int tid_ = threadIdx.x; asm volatile("" : "+v"(tid_));
    const int tid = tid_, wid = __builtin_amdgcn_readfirstlane(tid >> 6), lane = tid & 63, wr = wid >> 2, wc = wid & 3, fr = lane & 15, fq = lane >> 4;
    const int K = g.K, nt = K / BK;
    unsigned voffA[2], voffB[2];
#pragma unroll
    for (int i = 0; i < 2; ++i) { int R, C; stage_rc(tid * 16 + i * 8192, R, C); const int Rb = Epi::PERM ? ((R & ~31) + perm32(R & 31)) : R;
        voffA[i] = (unsigned)(R * g.lda + C) * 2u; voffB[i] = (unsigned)(Rb * g.ldb + C) * 2u; }
    const size_t kstep = (size_t)(BK * 2);
    const size_t hstepA = (size_t)HALF * g.lda * 2, hstepB = (size_t)HALF * g.ldb * 2;
    const unsigned ldsw = (unsigned)wid * 1024u;
    const int aoff = lds_byte(wr * 64 + fr, fq * 8), boff = lds_byte(wc * 32 + fr, fq * 8);
#define PG8_SA(b, h) (((b) * 2 + (h)) * HTB)
#define PG8_SB(b, h) ((4 + (b) * 2 + (h)) * HTB)
#define PG8_STAGE(bufoff, gbase, voff) do { _Pragma("unroll") for (int _i = 0; _i < 2; ++_i) \
        __builtin_amdgcn_global_load_lds((const unsigned*)((const char*)(gbase) + (voff)[_i]), (LAS unsigned*)(lds + (bufoff) + ldsw + _i * 8192), 16, 0, 0); } while (0)
#define PG8_LDA(dst, b, h) do { _Pragma("unroll") for (int m = 0; m < 4; ++m) _Pragma("unroll") for (int k = 0; k < 2; ++k) dst[m][k] = *(const LAS bf16x8*)(lds + PG8_SA(b, h) + aoff + m * 2048 + k * 1024); } while (0)
#define PG8_LDB(dst, b, h) do { _Pragma("unroll") for (int n = 0; n < 2; ++n) _Pragma("unroll") for (int k = 0; k < 2; ++k) dst[n][k] = *(const LAS bf16x8*)(lds + PG8_SB(b, h) + boff + n * 2048 + k * 1024); } while (0)
#define PG8_MMA(ai, bj, At, Bt) do { __builtin_amdgcn_s_setprio(1); _Pragma("unroll") for (int m = 0; m < 4; ++m) _Pragma("unroll") for (int n = 0; n < 2; ++n) { \
        if constexpr (FP8) { const i32x8 b8_ = __builtin_shufflevector(__builtin_bit_cast(i32x4, Bt[n][0]), __builtin_bit_cast(i32x4, Bt[n][1]), 0, 1, 2, 3, 4, 5, 6, 7); \
            const i32x8 a8_ = __builtin_shufflevector(__builtin_bit_cast(i32x4, At[m][0]), __builtin_bit_cast(i32x4, At[m][1]), 0, 1, 2, 3, 4, 5, 6, 7); \
            asm volatile("v_mfma_scale_f32_16x16x128_f8f6f4 %0, %1, %2, %0, %3, %3 op_sel_hi:[0,0,0]" : "+v"(acc[ai][bj][m][n]) : "v"(b8_), "v"(a8_), "v"(sc8_)); } \
        else { _Pragma("unroll") for (int k = 0; k < 2; ++k) acc[ai][bj][m][n] = __builtin_amdgcn_mfma_f32_16x16x32_bf16(Bt[n][k], At[m][k], acc[ai][bj][m][n], 0, 0, 0); } } \
        __builtin_amdgcn_s_setprio(0); } while (0)
#define PG8_WAIT_V(n) asm volatile("s_waitcnt vmcnt(" #n ")" ::: "memory")
#define PG8_WAIT_L(n) asm volatile("s_waitcnt lgkmcnt(" #n ")" ::: "memory")
#define PG8_BAR __builtin_amdgcn_s_barrier()
#define PG8_SCHED __builtin_amdgcn_sched_barrier(0)
    Unit cur, nxt; int ui = 0;
    if (!S.next(0, cur)) return;
    f32x4 acc[2][2][4][2];
#pragma unroll
    for (int a = 0; a < 2; ++a)
#pragma unroll
        for (int b = 0; b < 2; ++b)
#pragma unroll
            for (int m = 0; m < 4; ++m)
#pragma unroll
                for (int n = 0; n < 2; ++n) acc[a][b][m][n] = (f32x4){0.f, 0.f, 0.f, 0.f};
    bf16x8 At[4][2], B0[2][2], B1[2][2];
    const int sc8_ = 0x7f7f7f7f;
    (void)sc8_;
    const char* cA; const char* cB; S.ptrs(g, cur, cA, cB);
    PG8_STAGE(PG8_SB(0, 0), cB, voffB); PG8_STAGE(PG8_SB(0, 1), cB + hstepB, voffB); PG8_STAGE(PG8_SA(0, 0), cA, voffA); PG8_STAGE(PG8_SA(0, 1), cA + hstepA, voffA);
    E.table_fill(lds, S, tid);
    if (wr == 1) PG8_BAR;
    PG8_WAIT_V(2); PG8_BAR;
    PG8_STAGE(PG8_SB(1, 0), cB + kstep, voffB); PG8_STAGE(PG8_SA(1, 0), cA + kstep, voffA); PG8_STAGE(PG8_SB(1, 1), cB + hstepB + kstep, voffB);
    PG8_WAIT_V(6); PG8_BAR;
    for (;;) {
        const bool has_next = S.next(ui + 1, nxt);
        const char* nA = cA; const char* nB = cB; if (has_next) S.ptrs(g, nxt, nA, nB);
#pragma nounroll
        for (int t = 0; t < nt; t += 2) {
            const bool last = (t == nt - 2);
            const char* a1 = cA + (size_t)(t + 1) * kstep;
            const char* a2 = last ? nA : cA + (size_t)(t + 2) * kstep; const char* b2 = last ? nB : cB + (size_t)(t + 2) * kstep;
            const char* a3 = a2 + kstep; const char* b3 = b2 + kstep;
            PG8_LDB(B0, 0, 0); PG8_LDB(B1, 0, 1); PG8_SCHED; PG8_LDA(At, 0, 0); PG8_STAGE(PG8_SA(1, 1), a1 + hstepA, voffA);
            PG8_WAIT_V(8); PG8_WAIT_L(0); PG8_BAR; PG8_MMA(0, 0, At, B0); PG8_MMA(0, 1, At, B1); PG8_BAR; PG8_SCHED;
            PG8_LDA(At, 0, 1); PG8_STAGE(PG8_SB(0, 0), b2, voffB); PG8_STAGE(PG8_SB(0, 1), b2 + hstepB, voffB); PG8_STAGE(PG8_SA(0, 0), a2, voffA);
            PG8_WAIT_V(8); PG8_WAIT_L(0); PG8_BAR; PG8_MMA(1, 0, At, B0); PG8_MMA(1, 1, At, B1); PG8_BAR; PG8_SCHED;
            PG8_LDB(B0, 1, 0); PG8_LDB(B1, 1, 1); PG8_SCHED; PG8_LDA(At, 1, 0); PG8_STAGE(PG8_SA(0, 1), a2 + hstepA, voffA);
            PG8_WAIT_V(8); PG8_WAIT_L(0); PG8_BAR; PG8_MMA(0, 0, At, B0); PG8_MMA(0, 1, At, B1); PG8_BAR; PG8_SCHED;
            PG8_LDA(At, 1, 1); PG8_STAGE(PG8_SB(1, 0), b3, voffB); PG8_STAGE(PG8_SB(1, 1), b3 + hstepB, voffB); PG8_STAGE(PG8_SA(1, 0), a3, voffA);
            PG8_WAIT_V(8); PG8_WAIT_L(0); PG8_BAR; PG8_MMA(1, 0, At, B0); PG8_MMA(1, 1, At, B1); PG8_BAR; PG8_SCHED;
        }
        if (wr == 0) PG8_BAR;
        if constexpr (FP8) asm volatile("s_nop 15\n\ts_nop 15" ::: "memory");
        E(acc, cur, wr, wc, fr, fq, ui, lds);
        if (!has_next) break;
        if (!E.keep_acc(cur)) {
#pragma unroll
        for (int a = 0; a < 2; ++a)
#pragma unroll
            for (int b = 0; b < 2; ++b)
#pragma unroll
                for (int m = 0; m < 4; ++m)
#pragma unroll
                    for (int n = 0; n < 2; ++n) acc[a][b][m][n] = (f32x4){0.f, 0.f, 0.f, 0.f};
        }
        cur = nxt; cA = nA; cB = nB; ++ui;
        if (wr == 1) PG8_BAR;
    }
    PG8_WAIT_V(0);
    PG8_BAR;
#undef PG8_SA
#undef PG8_SB
#undef PG8_STAGE
#undef PG8_LDA
#undef PG8_LDB
#undef PG8_MMA
#undef PG8_WAIT_V
#undef PG8_WAIT_L
#undef PG8_BAR
#undef PG8_SCHED
}

__device__ __forceinline__ u32x4 pack8(const f32x4 v0, const f32x4 v1) { u32x4 w; w.x = cvt_pk_bf16(v0[0], v0[1]); w.y = cvt_pk_bf16(v0[2], v0[3]); w.z = cvt_pk_bf16(v1[0], v1[1]); w.w = cvt_pk_bf16(v1[2], v1[3]); return w; }
constexpr int RSTD_OFF = 131072 + 1024;
#define LOAD_RSTD(rs, tab, ui, wr, fr) float rs[2][4]; { const LAS float* t_ = (tab) + (ui) * 256 + (wr) * 64 + (fr); \
    _Pragma("unroll") for (int ai = 0; ai < 2; ++ai) _Pragma("unroll") for (int m = 0; m < 4; ++m) rs[ai][m] = t_[ai * HALF + m * 16]; }
template <class Sched>
__device__ __forceinline__ void rstd_table_fill(LAS unsigned char* lds, const float* ss, const Sched& S, int tid) {
    LAS float* tab = (LAS float*)(lds + RSTD_OFF);
    const int t = tid & 255, half = tid >> 8;
#pragma unroll
    for (int i = 0; i < 4; ++i) { Unit u; const int ui = i * 2 + half;
        if (S.next(ui, u)) tab[ui * 256 + t] = rsqrtf(ss[u.pm * BM + t] * (1.0f / 1024.0f) + EPS); }
    __syncthreads();
}

struct EpiProj {
    static constexpr bool PERM = true;
    bf16_t* O; const float* ss; const float* ba;
    __device__ __forceinline__ bool keep_acc(const Unit&) const { return false; }
    template <class Sched_> __device__ __forceinline__ void table_fill(LAS unsigned char* lds, const Sched_& S, int tid) const { rstd_table_fill(lds, ss, S, tid); }
    __device__ __forceinline__ void operator()(f32x4 (&acc)[2][2][4][2], const Unit& u, int wr, int wc, int fr, int fq, int ui, LAS unsigned char* lds) const {
        const int row0 = u.pm * BM + wr * 64 + fr, col0 = u.pn * BM + wc * 32 + 8 * fq;
        const bool isz = (u.pn == 12);
        LOAD_RSTD(rs, (const LAS float*)(lds + RSTD_OFF), ui, wr, fr)
        f32x4 bz[2][2];
#pragma unroll
        for (int bj = 0; bj < 2; ++bj)
#pragma unroll
            for (int n = 0; n < 2; ++n) bz[bj][n] = isz ? *(const f32x4*)(ba + (col0 - C_Z) + bj * HALF + 4 * n) : (f32x4){0.f, 0.f, 0.f, 0.f};
#pragma unroll
        for (int ai = 0; ai < 2; ++ai)
#pragma unroll
            for (int m = 0; m < 4; ++m) { const int row = row0 + ai * HALF + m * 16; const float r = rs[ai][m]; bf16_t* rowp = O + (size_t)row * NPROJ + col0;
#pragma unroll
                for (int bj = 0; bj < 2; ++bj) { f32x4 v0 = acc[ai][bj][m][0] * r, v1 = acc[ai][bj][m][1] * r;
                    if (isz) { v0 = v0 + bz[bj][0]; v1 = v1 + bz[bj][1];
#pragma unroll
                        for (int j = 0; j < 4; ++j) { v0[j] = glog_of(v0[j]); v1[j] = glog_of(v1[j]); } }
                    *(u32x4*)(rowp + bj * HALF) = pack8(v0, v1); } }
    }
};
struct EpiGate {
    static constexpr bool PERM = true;
    bf16_t* O; const float* ss; float zscale;
    __device__ __forceinline__ bool keep_acc(const Unit&) const { return false; }
    template <class Sched_> __device__ __forceinline__ void table_fill(LAS unsigned char* lds, const Sched_& S, int tid) const { rstd_table_fill(lds, ss, S, tid); }
    __device__ __forceinline__ void operator()(f32x4 (&acc)[2][2][4][2], const Unit& u, int wr, int wc, int fr, int fq, int ui, LAS unsigned char* lds) const {
        const int row0 = u.pm * BM + wr * 64 + fr, col0 = u.pn * BM + wc * 32 + 8 * fq;
        LOAD_RSTD(rs, (const LAS float*)(lds + RSTD_OFF), ui, wr, fr)
#pragma unroll
        for (int ai = 0; ai < 2; ++ai)
#pragma unroll
            for (int m = 0; m < 4; ++m) { const int row = row0 + ai * HALF + m * 16; const float r = rs[ai][m]; bf16_t* rowp = O + (size_t)row * NGATE + col0;
#pragma unroll
                for (int bj = 0; bj < 2; ++bj) { const float rz = r * zscale; f32x4 v0 = acc[ai][bj][m][0] * rz, v1 = acc[ai][bj][m][1] * rz;
#pragma unroll
                    for (int j = 0; j < 4; ++j) { v0[j] = fminf(1.f + __expf(-v0[j]), 1e30f); v1[j] = fminf(1.f + __expf(-v1[j]), 1e30f); }
                    *(u32x4*)(rowp + bj * HALF) = pack8(v0, v1); } }
    }
};
struct EpiUp {
    static constexpr bool PERM = true;
    bf16_t* O; const float* ss;
    __device__ __forceinline__ bool keep_acc(const Unit&) const { return false; }
    template <class Sched_> __device__ __forceinline__ void table_fill(LAS unsigned char* lds, const Sched_& S, int tid) const { rstd_table_fill(lds, ss, S, tid); }
    __device__ __forceinline__ void operator()(f32x4 (&acc)[2][2][4][2], const Unit& u, int wr, int wc, int fr, int fq, int ui, LAS unsigned char* lds) const {
        const int row0 = u.pm * BM + wr * 64 + fr, col0 = u.pn * BM + wc * 32 + 8 * fq;
        LOAD_RSTD(rs, (const LAS float*)(lds + RSTD_OFF), ui, wr, fr)
#pragma unroll
        for (int ai = 0; ai < 2; ++ai)
#pragma unroll
            for (int m = 0; m < 4; ++m) { const int row = row0 + ai * HALF + m * 16; const float r = rs[ai][m]; bf16_t* rowp = O + (size_t)row * DFF + col0;
#pragma unroll
                for (int bj = 0; bj < 2; ++bj) { f32x4 v0 = acc[ai][bj][m][0] * r, v1 = acc[ai][bj][m][1] * r;
#pragma unroll
                    for (int j = 0; j < 4; ++j) { const float a = fmaxf(v0[j], 0.f), b = fmaxf(v1[j], 0.f); v0[j] = a * a; v1[j] = b * b; }
                    *(u32x4*)(rowp + bj * HALF) = pack8(v0, v1); } }
    }
};
struct EpiBr {
    static constexpr bool PERM = true;
    const bf16_t* gates; bf16_t* mixed;
    __device__ __forceinline__ bool keep_acc(const Unit& u) const { return (u.pn >> 2) < 2; }
    template <class Sched_> __device__ __forceinline__ void table_fill(LAS unsigned char*, const Sched_&, int) const {}
    __device__ __forceinline__ void operator()(f32x4 (&acc)[2][2][4][2], const Unit& u, int wr, int wc, int fr, int fq, int ui, LAS unsigned char* lds) const {
        const int g = u.pn >> 2;
        const int row0 = u.pm * BM + wr * 64 + fr, col0 = (u.pn & 3) * BM + wc * 32 + 8 * fq;
        u32x4 ga[2][2][2], gb[2][2][2];
#define BR_LOAD(slot, q) do { _Pragma("unroll") for (int m2 = 0; m2 < 2; ++m2) _Pragma("unroll") for (int bj = 0; bj < 2; ++bj) { \
            const bf16_t* gp = gates + (size_t)(row0 + ((q) >> 1) * HALF + (((q) & 1) * 2 + m2) * 16) * NGATE + g * 1024 + col0 + bj * HALF; \
            ga[slot][m2][bj] = *(const u32x4*)gp; gb[slot][m2][bj] = (g < 2) ? *(const u32x4*)(gp + 1024) : (u32x4){0x3f803f80u, 0x3f803f80u, 0x3f803f80u, 0x3f803f80u}; } } while (0)
        BR_LOAD(0, 0); BR_LOAD(1, 1);
#pragma unroll
        for (int q = 0; q < 4; ++q) { const int ai = q >> 1, sl = q & 1;
#pragma unroll
            for (int m2 = 0; m2 < 2; ++m2)
#pragma unroll
                for (int bj = 0; bj < 2; ++bj) { const int m = (q & 1) * 2 + m2, row = row0 + ai * HALF + m * 16; const u32x4 a = ga[sl][m2][bj], b = gb[sl][m2][bj];
                    float f[8];
#pragma unroll
                    for (int e = 0; e < 4; ++e) { f[2 * e] = bflo(b[e]) * __builtin_amdgcn_rcpf(bflo(a[e])); f[2 * e + 1] = bfhi(b[e]) * __builtin_amdgcn_rcpf(bfhi(a[e])); }
                    f32x4 v0 = acc[ai][bj][m][0], v1 = acc[ai][bj][m][1];
                    v0[0] *= f[0]; v0[1] *= f[1]; v0[2] *= f[2]; v0[3] *= f[3]; v1[0] *= f[4]; v1[1] *= f[5]; v1[2] *= f[6]; v1[3] *= f[7];
                    if (g < 2) { acc[ai][bj][m][0] = v0; acc[ai][bj][m][1] = v1; }
                    else *(u32x4*)(mixed + (size_t)row * D + col0 + bj * HALF) = pack8(v0, v1); }
            asm volatile("" ::: "memory");
            if (q == 0) BR_LOAD(0, 2);
            if (q == 1) BR_LOAD(1, 3);
        }
#undef BR_LOAD
    }
};
struct EpiRes {
    static constexpr bool PERM = true;
    float* xout; bf16_t* xb; float* ss; unsigned char* xb8;
    __device__ __forceinline__ bool keep_acc(const Unit&) const { return false; }
    template <class Sched_> __device__ __forceinline__ void table_fill(LAS unsigned char*, const Sched_&, int) const {}
    __device__ __forceinline__ void operator()(f32x4 (&acc)[2][2][4][2], const Unit& u, int wr, int wc, int fr, int fq, int ui, LAS unsigned char* lds) const {
        const int row0 = u.pm * BM + wr * 64 + fr, col0 = u.pn * BM + wc * 32 + 8 * fq;
#pragma unroll
        for (int ai = 0; ai < 2; ++ai) {
            u32x4 xv[4][2];
#pragma unroll
            for (int m = 0; m < 4; ++m)
#pragma unroll
                for (int bj = 0; bj < 2; ++bj) xv[m][bj] = *(const u32x4*)(xb + (size_t)(row0 + ai * HALF + m * 16) * D + col0 + bj * HALF);
#pragma unroll
            for (int m = 0; m < 4; ++m) { const int row = row0 + ai * HALF + m * 16; float sq = 0.f;
#pragma unroll
                for (int bj = 0; bj < 2; ++bj) { const size_t off = (size_t)row * D + col0 + bj * HALF; const u32x4 w = xv[m][bj];
                    f32x4 x0 = acc[ai][bj][m][0], x1 = acc[ai][bj][m][1];
                    x0[0] += bflo(w.x); x0[1] += bfhi(w.x); x0[2] += bflo(w.y); x0[3] += bfhi(w.y); x1[0] += bflo(w.z); x1[1] += bfhi(w.z); x1[2] += bflo(w.w); x1[3] += bfhi(w.w);
                    if (xout) { *(f32x4*)(xout + off) = x0; *(f32x4*)(xout + off + 4) = x1; }
                    sq += (x0[0] * x0[0] + x0[1] * x0[1]) + (x0[2] * x0[2] + x0[3] * x0[3]) + (x1[0] * x1[0] + x1[1] * x1[1]) + (x1[2] * x1[2] + x1[3] * x1[3]);
                    if (!xout) *(u32x4*)(xb + off) = pack8(x0, x1);
                    if (xb8) { u32x2 o8; o8.x = pk4_fp8(x0[0], x0[1], x0[2], x0[3]); o8.y = pk4_fp8(x1[0], x1[1], x1[2], x1[3]); *(u32x2*)(xb8 + off) = o8; } }
                sq += __shfl_xor(sq, 16); sq += __shfl_xor(sq, 32);
                if (fq == 0 && !xout) (void)__hip_atomic_fetch_add(ss + row, sq, __ATOMIC_RELAXED, __HIP_MEMORY_SCOPE_AGENT); }
            asm volatile("" ::: "memory");
        }
    }
};
}

struct Args {
    const float *x; const int* pos; const float *norm1_w, *w_in, *conv_w, *conv_b, *gla_wa2, *gla_ba, *gla_onorm_w, *q_norm_w, *k_norm_w, *sinks, *w_branch, *w_o, *norm2_w, *w_up, *w_down;
    float* out; unsigned char* ws;
};


__device__ __forceinline__ unsigned char* wptr(const Args& a, unsigned char* ws, int l, size_t off) { return l == 0 ? ws + off : (unsigned char*)a.out + DO_W1 + (off - WS_WIN); }
__device__ __forceinline__ unsigned char* wdn_ptr(unsigned char* ws, int l) { return l == 0 ? ws + WS_WDN : ws + WS_WDN1; }
template <class F>
__device__ __forceinline__ void transpose_items(F src4, int K, int N, bf16_t* WT, LAS float* scr, int gw, int NGW, int lane) {
    const int nblk = N / 32, nitems = (K / 64) * nblk;
    const int r8 = lane >> 3, c4 = lane & 7;
    for (int it = gw; it < nitems; it += NGW) {
        const int kb = it / nblk, nb = it - kb * nblk, k0 = 64 * kb, n0 = 32 * nb;
        f32x4 v[8];
#pragma unroll
        for (int i = 0; i < 8; ++i) v[i] = src4(k0 + i * 8 + r8, n0 + c4 * 4);
#pragma unroll
        for (int i = 0; i < 8; ++i) { LAS float* d = scr + (i * 8 + r8) * 33 + c4 * 4; d[0] = v[i][0]; d[1] = v[i][1]; d[2] = v[i][2]; d[3] = v[i][3]; }
        LDS_WAIT();
        const int c = lane & 7;
#pragma unroll
        for (int j = 0; j < 4; ++j) { const int n = (lane >> 3) + 8 * j; const LAS float* sp = scr + (8 * c) * 33 + n;
            u32x4 o; o.x = cvt_pk_bf16(sp[0 * 33], sp[1 * 33]); o.y = cvt_pk_bf16(sp[2 * 33], sp[3 * 33]); o.z = cvt_pk_bf16(sp[4 * 33], sp[5 * 33]); o.w = cvt_pk_bf16(sp[6 * 33], sp[7 * 33]);
            *(u32x4*)(WT + (size_t)(n0 + n) * K + k0 + 8 * c) = o; }
        LDS_WAIT();
    }
}
__device__ __forceinline__ void conv_w_in_main(const Args& a, unsigned char* ws, LAS float* scr, int l, int gw, int NGW, int lane) {
    const float* W = a.w_in + (size_t)l * D * NIN; const float* nw = a.norm1_w + l * D; const float* wa2 = a.gla_wa2 + l * 16 * 256;
    auto src = [=](int k, int n) -> f32x4 {
        const float* wr = W + (size_t)k * NIN; f32x4 v;
        if (n < C_Z) v = *(const f32x4*)(wr + n);
        else if (n < C_SQ) { v = (f32x4){0.f, 0.f, 0.f, 0.f};
#pragma unroll
            for (int r4 = 0; r4 < 4; ++r4) { const f32x4 g = *(const f32x4*)(wr + 3072 + r4 * 4);
#pragma unroll
                for (int rr = 0; rr < 4; ++rr) v = v + g[rr] * *(const f32x4*)(wa2 + (r4 * 4 + rr) * 256 + (n - C_Z)); } }
        else v = *(const f32x4*)(wr + n - 240);
        return v * nw[k]; };
    transpose_items(src, D, NPROJ, (bf16_t*)wptr(a, ws, l, WS_WIN), scr, gw, NGW, lane);
}
__device__ __forceinline__ void conv_w_gate(const Args& a, unsigned char* ws, LAS float* scr, int l, int gw, int NGW, int lane);
template <class F>
__device__ __forceinline__ void transpose_items_fp8(F src4, int K, int N, unsigned char* WT, LAS float* scr, int gw, int NGW, int lane) {
    const int nblk = N / 32, nitems = (K / 64) * nblk;
    const int r8 = lane >> 3, c4 = lane & 7;
    for (int it = gw; it < nitems; it += NGW) {
        const int kb = it / nblk, nb = it - kb * nblk, k0 = 64 * kb, n0 = 32 * nb;
        f32x4 v[8];
#pragma unroll
        for (int i = 0; i < 8; ++i) v[i] = src4(k0 + i * 8 + r8, n0 + c4 * 4);
#pragma unroll
        for (int i = 0; i < 8; ++i) { LAS float* d = scr + (i * 8 + r8) * 33 + c4 * 4; d[0] = v[i][0]; d[1] = v[i][1]; d[2] = v[i][2]; d[3] = v[i][3]; }
        LDS_WAIT();
        const int c = lane & 7;
#pragma unroll
        for (int j = 0; j < 4; ++j) { const int n = (lane >> 3) + 8 * j; const LAS float* sp = scr + (8 * c) * 33 + n;
            u32x2 o; o.x = pk4_fp8(sp[0 * 33], sp[1 * 33], sp[2 * 33], sp[3 * 33]); o.y = pk4_fp8(sp[4 * 33], sp[5 * 33], sp[6 * 33], sp[7 * 33]);
            *(u32x2*)(WT + (size_t)(n0 + n) * K + k0 + 8 * c) = o; }
        LDS_WAIT();
    }
}
__device__ __forceinline__ void conv_w_gate(const Args& a, unsigned char* ws, LAS float* scr, int l, int gw, int NGW, int lane) {
    const float* W = a.w_in + (size_t)l * D * NIN + 3856; const float* nw = a.norm1_w + l * D;
    auto src = [=](int k, int n) -> f32x4 { return *(const f32x4*)(W + (size_t)k * NIN + n) * (nw[k] * WG8_SCALE); };
    transpose_items_fp8(src, D, NGATE, wptr(a, ws, l, WS_WG), scr, gw, NGW, lane);
}
__device__ __forceinline__ void conv_w_br(const Args& a, unsigned char* ws, LAS float* scr, int l, int gw, int NGW, int lane) {
    for (int g = 0; g < 3; ++g) { const float* W = a.w_branch + ((size_t)l * 3 + g) * 512 * 1024;
        auto src = [=](int k, int n) -> f32x4 { return *(const f32x4*)(W + (size_t)k * 1024 + n); };
        transpose_items(src, 512, 1024, (bf16_t*)wptr(a, ws, l, WS_WBR) + (size_t)g * 1024 * 512, scr, gw, NGW, lane); }
}
__device__ __forceinline__ void conv_w_o(const Args& a, unsigned char* ws, LAS float* scr, int l, int gw, int NGW, int lane) {
    const float* W = a.w_o + (size_t)l * D * D;
    auto src = [=](int k, int n) -> f32x4 { return *(const f32x4*)(W + (size_t)k * D + n); };
    transpose_items(src, D, D, (bf16_t*)wptr(a, ws, l, WS_WO), scr, gw, NGW, lane);
}
__device__ __forceinline__ void conv_w_up(const Args& a, unsigned char* ws, LAS float* scr, int l, int gw, int NGW, int lane) {
    const float* W = a.w_up + (size_t)l * D * DFF; const float* nw = a.norm2_w + l * D;
    auto src = [=](int k, int n) -> f32x4 { return *(const f32x4*)(W + (size_t)k * DFF + n) * nw[k]; };
    transpose_items(src, D, DFF, (bf16_t*)wptr(a, ws, l, WS_WUP), scr, gw, NGW, lane);
}
__device__ __forceinline__ void conv_w_dn(const Args& a, unsigned char* ws, LAS float* scr, int l, int gw, int NGW, int lane) {
    const float* W = a.w_down + (size_t)l * DFF * D;
    auto src = [=](int k, int n) -> f32x4 { return *(const f32x4*)(W + (size_t)k * D + n); };
    transpose_items(src, DFF, D, (bf16_t*)wdn_ptr(ws, l), scr, gw, NGW, lane);
}
__device__ __forceinline__ float wave_sum(float v) {
#pragma unroll
    for (int o = 1; o < 64; o <<= 1) v += __shfl_xor(v, o);
    return v;
}

__device__ __forceinline__ void conv_phase(const Args& a, unsigned char* ws, int l, int gtid, int gsz) {
    const bf16_t* P = (const bf16_t*)(ws + WS_PROJ); bf16_t* Y = (bf16_t*)(ws + WS_Y);
    const float* cw = a.conv_w + l * 3 * 512; const float* cb = a.conv_b + l * 512;
    for (int id = gtid; id < (M / 16) * 64; id += gsz) {
        const int c = (id & 63) * 8, r0 = (id >> 6) * 16;
        float w0[8], w1[8], w2[8], bb[8], um1[8], um2[8];
#pragma unroll
        for (int j = 0; j < 8; ++j) { w0[j] = cw[c + j]; w1[j] = cw[512 + c + j]; w2[j] = cw[1024 + c + j]; bb[j] = cb[c + j]; um1[j] = 0.f; um2[j] = 0.f; }
        if ((r0 & (SEQ - 1)) != 0) {
            const u32x4 x1 = *(const u32x4*)(P + (size_t)(r0 - 1) * NPROJ + C_CX + c), c1 = *(const u32x4*)(P + (size_t)(r0 - 1) * NPROJ + C_CC + c);
            const u32x4 x2 = *(const u32x4*)(P + (size_t)(r0 - 2) * NPROJ + C_CX + c), c2 = *(const u32x4*)(P + (size_t)(r0 - 2) * NPROJ + C_CC + c);
#pragma unroll
            for (int j = 0; j < 4; ++j) { um1[2 * j] = bflo(x1[j]) * bflo(c1[j]); um1[2 * j + 1] = bfhi(x1[j]) * bfhi(c1[j]); um2[2 * j] = bflo(x2[j]) * bflo(c2[j]); um2[2 * j + 1] = bfhi(x2[j]) * bfhi(c2[j]); }
        }
#pragma unroll
        for (int hb = 0; hb < 2; ++hb) {
            u32x4 xa[8], ba[8], ca[8];
#pragma unroll
            for (int i = 0; i < 8; ++i) { const size_t ro = (size_t)(r0 + hb * 8 + i) * NPROJ + c; xa[i] = *(const u32x4*)(P + ro + C_CX); ba[i] = *(const u32x4*)(P + ro + C_CB); ca[i] = *(const u32x4*)(P + ro + C_CC); }
#pragma unroll
            for (int i = 0; i < 8; ++i) { const u32x4 xv = xa[i], bv = ba[i], cv = ca[i];
                float u[8], y[8];
#pragma unroll
                for (int j = 0; j < 4; ++j) { u[2 * j] = bflo(xv[j]) * bflo(cv[j]); u[2 * j + 1] = bfhi(xv[j]) * bfhi(cv[j]); }
#pragma unroll
                for (int j = 0; j < 4; ++j) {
                    y[2 * j] = bflo(bv[j]) * (w0[2 * j] * um2[2 * j] + w1[2 * j] * um1[2 * j] + w2[2 * j] * u[2 * j] + bb[2 * j]);
                    y[2 * j + 1] = bfhi(bv[j]) * (w0[2 * j + 1] * um2[2 * j + 1] + w1[2 * j + 1] * um1[2 * j + 1] + w2[2 * j + 1] * u[2 * j + 1] + bb[2 * j + 1]); }
                u32x4 o; o.x = cvt_pk_bf16(y[0], y[1]); o.y = cvt_pk_bf16(y[2], y[3]); o.z = cvt_pk_bf16(y[4], y[5]); o.w = cvt_pk_bf16(y[6], y[7]);
                *(u32x4*)(Y + (size_t)(r0 + hb * 8 + i) * YW + c) = o;
#pragma unroll
                for (int j = 0; j < 8; ++j) { um2[j] = um1[j]; um1[j] = u[j]; }
            }
        }
    }
}

constexpr int SW_KS = 0, SW_VT = 36864, SW_QS = SW_VT + 33792;
__device__ __forceinline__ void qk_row_norm_rope(float (&v)[16], const float (&nw16)[16], int part, float scale, int pos, bool dorope) {
    float ss = 0.f;
#pragma unroll
    for (int i = 0; i < 16; ++i) ss += v[i] * v[i];
    ss += __shfl_xor(ss, 1); ss += __shfl_xor(ss, 2);
    const float rs = rsqrtf(ss * (1.0f / 64.0f) + EPS) ;
#pragma unroll
    for (int i = 0; i < 16; ++i) v[i] = v[i] * rs * nw16[i];
    if (part == 0 && dorope) {
        const float p = (float)pos;
#pragma unroll
        for (int i = 0; i < 8; ++i) {
            const float invf = exp2f(-(float)i * 2.3664460711655217f);
            float rev = p * invf * 0.15915494309189535f; rev = rev - floorf(rev);
            const float sn = __builtin_amdgcn_sinf(rev), cs = __builtin_amdgcn_cosf(rev);
            const float x1 = v[i], x2 = v[i + 8];
            v[i] = x1 * cs - x2 * sn; v[i + 8] = x2 * cs + x1 * sn; }
    }
#pragma unroll
    for (int i = 0; i < 16; ++i) v[i] *= scale;
}
#define SWA_QLOAD(gg) do { const int q_ = tid >> 2, part_ = tid & 3, t_ = qblk * 128 + q_; const size_t ro_ = (size_t)(b * SEQ + t_) * NPROJ + C_SQ + (kvh * 4 + (gg)) * 64 + part_ * 16; \
        qa0 = *(const u32x4*)(P + ro_); qa1 = *(const u32x4*)(P + ro_ + 8); qpos = a.pos[b * SEQ + t_]; } while (0)
#define SWA_QSTAGE(dst) do { const int q_ = tid >> 2, part_ = tid & 3; float v_[16]; \
        _Pragma("unroll") for (int j_ = 0; j_ < 4; ++j_) { v_[2 * j_] = bflo(qa0[j_]); v_[2 * j_ + 1] = bfhi(qa0[j_]); v_[8 + 2 * j_] = bflo(qa1[j_]); v_[8 + 2 * j_ + 1] = bfhi(qa1[j_]); } \
        qk_row_norm_rope(v_, qw16, part_, 0.125f, qpos, true); u32x4 o0_, o1_; \
        o0_.x = cvt_pk_bf16(v_[0], v_[1]); o0_.y = cvt_pk_bf16(v_[2], v_[3]); o0_.z = cvt_pk_bf16(v_[4], v_[5]); o0_.w = cvt_pk_bf16(v_[6], v_[7]); \
        o1_.x = cvt_pk_bf16(v_[8], v_[9]); o1_.y = cvt_pk_bf16(v_[10], v_[11]); o1_.z = cvt_pk_bf16(v_[12], v_[13]); o1_.w = cvt_pk_bf16(v_[14], v_[15]); \
        *(LAS u32x4*)((dst) + q_ * 72 + part_ * 16) = o0_; *(LAS u32x4*)((dst) + q_ * 72 + part_ * 16 + 8) = o1_; } while (0)
__device__ __forceinline__ void swa_phase(const Args& a, unsigned char* ws, LAS unsigned char* lds, int l, int bid, int G) {
    const bf16_t* P = (const bf16_t*)(ws + WS_PROJ); bf16_t* Y = (bf16_t*)(ws + WS_Y);
    int tid_ = threadIdx.x; asm volatile("" : "+v"(tid_));
    const int tid = tid_, lane = tid & 63, w = __builtin_amdgcn_readfirstlane(tid >> 6), fr = lane & 15, fq = lane >> 4;
    const float* qnw = a.q_norm_w + l * 64; const float* knw = a.k_norm_w + l * 64; const float* sinks = a.sinks + l * 8;
    LAS bf16_t* Ks = (LAS bf16_t*)(lds + SW_KS); LAS bf16_t* Vt = (LAS bf16_t*)(lds + SW_VT); LAS bf16_t* Qs = (LAS bf16_t*)(lds + SW_QS);
    float kw16[16], qw16[16];
#pragma unroll
    for (int i = 0; i < 16; ++i) { kw16[i] = knw[(tid & 3) * 16 + i]; qw16[i] = qnw[(tid & 3) * 16 + i]; }
    for (int task = bid; task < 512; task += G) {
        const int b = task >> 5, kvh = (task >> 4) & 1, qblk = task & 15;
        __syncthreads();
#pragma unroll
        for (int pass = 0; pass < 2; ++pass) {
            const int idx = pass * 512 + tid, key = idx >> 2, part = idx & 3, kpos = (qblk - 1) * 128 + key;
            float v[16]; int pos = 0;
            if (kpos >= 0) { const size_t ro = (size_t)(b * SEQ + kpos) * NPROJ + C_SK + kvh * 64 + part * 16;
                const u32x4 a0 = *(const u32x4*)(P + ro), a1 = *(const u32x4*)(P + ro + 8);
#pragma unroll
                for (int j = 0; j < 4; ++j) { v[2 * j] = bflo(a0[j]); v[2 * j + 1] = bfhi(a0[j]); v[8 + 2 * j] = bflo(a1[j]); v[8 + 2 * j + 1] = bfhi(a1[j]); }
                pos = a.pos[b * SEQ + kpos];
            } else {
#pragma unroll
                for (int i = 0; i < 16; ++i) v[i] = 0.f; }
            qk_row_norm_rope(v, kw16, part, 1.0f, pos, kpos >= 0);
            u32x4 o0, o1;
            o0.x = cvt_pk_bf16(v[0], v[1]); o0.y = cvt_pk_bf16(v[2], v[3]); o0.z = cvt_pk_bf16(v[4], v[5]); o0.w = cvt_pk_bf16(v[6], v[7]);
            o1.x = cvt_pk_bf16(v[8], v[9]); o1.y = cvt_pk_bf16(v[10], v[11]); o1.z = cvt_pk_bf16(v[12], v[13]); o1.w = cvt_pk_bf16(v[14], v[15]);
            *(LAS u32x4*)(Ks + key * 72 + part * 16) = o0; *(LAS u32x4*)(Ks + key * 72 + part * 16 + 8) = o1;
        }
#pragma unroll
        for (int pass = 0; pass < 4; ++pass) {
            const int idx = pass * 512 + tid, key = idx & 255, c8 = idx >> 8, kpos = (qblk - 1) * 128 + key;
            u32x4 vv = (u32x4){0u, 0u, 0u, 0u};
            if (kpos >= 0) vv = *(const u32x4*)(P + (size_t)(b * SEQ + kpos) * NPROJ + C_SV + kvh * 64 + c8 * 8);
#pragma unroll
            for (int j = 0; j < 4; ++j) { Vt[(c8 * 8 + 2 * j) * 264 + key] = (bf16_t)(vv[j] & 0xffffu); Vt[(c8 * 8 + 2 * j + 1) * 264 + key] = (bf16_t)(vv[j] >> 16); }
        }
        u32x4 qa0, qa1; int qpos;
        SWA_QLOAD(0); SWA_QSTAGE(Qs); SWA_QLOAD(1);
        for (int g = 0; g < 4; ++g) {
            LAS bf16_t* Qg = Qs + (g & 1) * (128 * 72);
            const int h = kvh * 4 + g;
            __syncthreads();
            bf16x8 qf[2];
#pragma unroll
            for (int ks = 0; ks < 2; ++ks) qf[ks] = *(const LAS bf16x8*)(Qg + (16 * w + fr) * 72 + ks * 32 + fq * 8);
            f32x4 s[9];
#pragma unroll
            for (int tt = 0; tt < 9; ++tt) { s[tt] = (f32x4){0.f, 0.f, 0.f, 0.f};
#pragma unroll
                for (int ks = 0; ks < 2; ++ks) { const bf16x8 ka = *(const LAS bf16x8*)(Ks + ((w + tt) * 16 + fr) * 72 + ks * 32 + fq * 8);
                    s[tt] = __builtin_amdgcn_mfma_f32_16x16x32_bf16(ka, qf[ks], s[tt], 0, 0, 0); } }
            const float sink = sinks[h];
            const int qi = 16 * w + fr;
            float mx = -3.0e38f;
#pragma unroll
            for (int tt = 0; tt < 9; ++tt)
#pragma unroll
                for (int j = 0; j < 4; ++j) { const int c = (w + tt) * 16 + fq * 4 + j; const bool ok = (c > qi) && (c <= qi + 128) && (qblk > 0 || c >= 128);
                    s[tt][j] = ok ? s[tt][j] : -3.0e38f; mx = fmaxf(mx, s[tt][j]); }
            mx = fmaxf(mx, __shfl_xor(mx, 16)); mx = fmaxf(mx, __shfl_xor(mx, 32));
            const float mm = fmaxf(mx, sink);
            float sum = 0.f;
#pragma unroll
            for (int tt = 0; tt < 9; ++tt)
#pragma unroll
                for (int j = 0; j < 4; ++j) { const float p = (s[tt][j] > -1.0e38f) ? __expf(s[tt][j] - mm) : 0.f; s[tt][j] = p; sum += p; }
            sum += __shfl_xor(sum, 16); sum += __shfl_xor(sum, 32);
            const float inv = 1.0f / (sum + __expf(sink - mm));
            f32x4 o[4];
#pragma unroll
            for (int dt = 0; dt < 4; ++dt) o[dt] = (f32x4){0.f, 0.f, 0.f, 0.f};
#pragma unroll
            for (int kp = 0; kp < 5; ++kp) {
                const int t0 = 2 * kp, t1 = 2 * kp + 1;
                union { u32x4 u; bf16x8 h; } pb;
                pb.u.x = cvt_pk_bf16(s[t0][0], s[t0][1]); pb.u.y = cvt_pk_bf16(s[t0][2], s[t0][3]);
                if (t1 < 9) { pb.u.z = cvt_pk_bf16(s[t1 < 9 ? t1 : 0][0], s[t1 < 9 ? t1 : 0][1]); pb.u.w = cvt_pk_bf16(s[t1 < 9 ? t1 : 0][2], s[t1 < 9 ? t1 : 0][3]); } else { pb.u.z = 0u; pb.u.w = 0u; }
#pragma unroll
                for (int dt = 0; dt < 4; ++dt) {
                    union { u32x4 u; bf16x8 h; } va;
                    const u32x2 lo = *(const LAS u32x2*)(Vt + (dt * 16 + fr) * 264 + (w + t0) * 16 + fq * 4);
                    u32x2 hi = (u32x2){0u, 0u};
                    if (t1 < 9) hi = *(const LAS u32x2*)(Vt + (dt * 16 + fr) * 264 + (w + (t1 < 9 ? t1 : 0)) * 16 + fq * 4);
                    va.u.x = lo.x; va.u.y = lo.y; va.u.z = hi.x; va.u.w = hi.y;
                    o[dt] = __builtin_amdgcn_mfma_f32_16x16x32_bf16(va.h, pb.h, o[dt], 0, 0, 0); }
            }
            const size_t yo = (size_t)(b * SEQ + qblk * 128 + qi) * YW + 1024 + h * 64 + fq * 4;
#pragma unroll
            for (int dt = 0; dt < 4; ++dt) { u32x2 ov; ov.x = cvt_pk_bf16(o[dt][0] * inv, o[dt][1] * inv); ov.y = cvt_pk_bf16(o[dt][2] * inv, o[dt][3] * inv); *(u32x2*)(Y + yo + dt * 16) = ov; }
            if (g < 3) { SWA_QSTAGE(Qs + ((g + 1) & 1) * (128 * 72)); if (g < 2) SWA_QLOAD(g + 2); }
        }
    }
    __syncthreads();
}

#undef SWA_QLOAD
#undef SWA_QSTAGE
constexpr int GL_KE = 0, GL_VT = 9216, GL_QS = GL_VT + 18432, GL_ST = GL_QS + 9216, GL_TOT = GL_ST + 18432, GL_RED = GL_TOT + 2048;
struct GlaRegs { unsigned short g[8], k[8], q[8], v[16]; u32x4 st[2]; u32x2 r[4]; f32x4 pc[2]; };
template <bool STEP3>
__device__ __forceinline__ void gla_load(GlaRegs& R, const bf16_t* P, const bf16_t* ST, const float* PC, int c, int seg, int d, int tid, int w, int fr, int fq) {
    const int bh = c >> 5, n = c & 31, b = bh >> 2, h = bh & 3, row0 = b * SEQ + n * 64;
#pragma unroll
    for (int i = 0; i < 8; ++i) { const size_t ro = (size_t)(row0 + seg * 8 + i) * NPROJ + h * 64 + d;
        R.g[i] = P[ro + C_Z]; R.k[i] = P[ro + C_GK]; if (STEP3) R.q[i] = P[ro + C_GQ]; }
#pragma unroll
    for (int half = 0; half < 2; ++half)
#pragma unroll
        for (int i = 0; i < 8; ++i) R.v[half * 8 + i] = P[(size_t)(row0 + seg * 8 + i) * NPROJ + C_GV + h * 128 + half * 64 + d];
    if (STEP3) {
#pragma unroll
        for (int j = 0; j < 2; ++j) { const int idx = j * 512 + tid, v = idx >> 3, c8 = idx & 7; R.st[j] = *(const u32x4*)(ST + ((size_t)c * 128 + v) * 64 + c8 * 8); }
        R.pc[0] = *(const f32x4*)(PC + (size_t)c * 64 + (tid & 7) * 8); R.pc[1] = *(const f32x4*)(PC + (size_t)c * 64 + (tid & 7) * 8 + 4);
        const int it = w >> 1, vh = w & 1, row = row0 + it * 16 + fr;
#pragma unroll
        for (int x = 0; x < 4; ++x) R.r[x] = *(const u32x2*)(P + (size_t)row * NPROJ + C_GR + h * 128 + (vh * 4 + x) * 16 + fq * 4);
    }
}
__device__ __forceinline__ void gla_cumsum(const GlaRegs& R, LAS float* tot, int seg, int d, float (&bv)[8], float& blast) {
#pragma unroll
    for (int i = 0; i < 8; ++i) bv[i] = bf2f(R.g[i]);
#pragma unroll
    for (int i = 1; i < 8; ++i) bv[i] += bv[i - 1];
    tot[seg * 64 + d] = bv[7];
    __syncthreads();
    float off = 0.f, all = 0.f;
#pragma unroll
    for (int s = 0; s < 8; ++s) { const float t = tot[s * 64 + d]; all += t; off += (s < seg) ? t : 0.f; }
#pragma unroll
    for (int i = 0; i < 8; ++i) bv[i] += off;
    blast = all;
}
__device__ __forceinline__ void gla_stage_v(const GlaRegs& R, LAS bf16_t* Vt, int seg, int d) {
#pragma unroll
    for (int half = 0; half < 2; ++half) { const int v = half * 64 + d; const unsigned short* e = R.v + half * 8;
        u32x4 o; o.x = e[0] | ((unsigned)e[1] << 16); o.y = e[2] | ((unsigned)e[3] << 16); o.z = e[4] | ((unsigned)e[5] << 16); o.w = e[6] | ((unsigned)e[7] << 16);
        *(LAS u32x4*)(Vt + v * 72 + seg * 8) = o; }
}
constexpr int GL_DECL = GL_RED + 512, GL_CS = 65536;
__device__ __forceinline__ void gla1_phase(const Args& a, unsigned char* ws, LAS unsigned char* lds, int bid, int G) {
    const bf16_t* P = (const bf16_t*)(ws + WS_PROJ); bf16_t* ST = (bf16_t*)(ws + WS_S);
    float* AGG = (float*)((unsigned char*)a.out + DO_AGG); float* PC = (float*)((unsigned char*)a.out + DO_PC); float* AGGD = (float*)((unsigned char*)a.out + DO_AGGD);
    int tid_ = threadIdx.x; asm volatile("" : "+v"(tid_));
    const int tid = tid_, lane = tid & 63, w = __builtin_amdgcn_readfirstlane(tid >> 6), fr = lane & 15, fq = lane >> 4, seg = tid >> 6, d = tid & 63;
    LAS bf16_t* KEt = (LAS bf16_t*)(lds + GL_KE); LAS bf16_t* Vt = (LAS bf16_t*)(lds + GL_VT); LAS float* tot = (LAS float*)(lds + GL_TOT); LAS float* declds = (LAS float*)(lds + GL_DECL);
    GlaRegs R;
    if (bid < 256) gla_load<false>(R, P, ST, PC, bid * 8, seg, d, tid, w, fr, fq);
    for (int r = bid; r < 256; r += G) {
        f32x4 sl[4];
#pragma unroll
        for (int dt = 0; dt < 4; ++dt) sl[dt] = (f32x4){0.f, 0.f, 0.f, 0.f};
        float prun = 1.0f;
        for (int i = 0; i < 8; ++i) {
            const int c = r * 8 + i;
            __syncthreads();
            float bv[8], blast; gla_cumsum(R, tot, seg, d, bv, blast);
            float ke[8];
#pragma unroll
            for (int e = 0; e < 8; ++e) ke[e] = bf2f(R.k[e]) * __expf(blast - bv[e]);
            u32x4 o; o.x = cvt_pk_bf16(ke[0], ke[1]); o.y = cvt_pk_bf16(ke[2], ke[3]); o.z = cvt_pk_bf16(ke[4], ke[5]); o.w = cvt_pk_bf16(ke[6], ke[7]);
            *(LAS u32x4*)(KEt + d * 72 + seg * 8) = o;
            if (seg == 0) { PC[(size_t)c * 64 + d] = prun; const float ed = __expf(blast); declds[d] = ed; prun *= ed; }
            gla_stage_v(R, Vt, seg, d);
            { const int cn = (i < 7) ? c + 1 : (r + G) * 8; if (cn < 2048) gla_load<false>(R, P, ST, PC, cn, seg, d, tid, w, fr, fq); }
            __syncthreads();
            f32x4 acc[4];
#pragma unroll
            for (int dt = 0; dt < 4; ++dt) acc[dt] = (f32x4){0.f, 0.f, 0.f, 0.f};
#pragma unroll
            for (int ks = 0; ks < 2; ++ks) { const bf16x8 vb = *(const LAS bf16x8*)(Vt + (w * 16 + fr) * 72 + ks * 32 + fq * 8);
#pragma unroll
                for (int dt = 0; dt < 4; ++dt) { const bf16x8 ka = *(const LAS bf16x8*)(KEt + (dt * 16 + fr) * 72 + ks * 32 + fq * 8);
                    acc[dt] = __builtin_amdgcn_mfma_f32_16x16x32_bf16(ka, vb, acc[dt], 0, 0, 0); } }
#pragma unroll
            for (int dt = 0; dt < 4; ++dt) { const f32x4 dv = *(const LAS f32x4*)(declds + dt * 16 + fq * 4);
                u32x2 ov; ov.x = cvt_pk_bf16(sl[dt][0], sl[dt][1]); ov.y = cvt_pk_bf16(sl[dt][2], sl[dt][3]);
                *(u32x2*)(ST + ((size_t)c * 128 + w * 16 + fr) * 64 + dt * 16 + fq * 4) = ov;
                sl[dt] = dv * sl[dt] + acc[dt]; }
        }
#pragma unroll
        for (int dt = 0; dt < 4; ++dt) *(f32x4*)(AGG + ((size_t)r * 128 + w * 16 + fr) * 64 + dt * 16 + fq * 4) = sl[dt];
        if (seg == 0) AGGD[r * 64 + d] = prun;
    }
    __syncthreads();
}
__device__ __forceinline__ void gla_scan_phase(unsigned char* ws, int gtid, int gsz) {
    bf16_t* ST = (bf16_t*)(ws + WS_S); const float* dec = (const float*)(ws + WS_DEC);
    for (int id = gtid; id < 65536; id += gsz) {
        const int dg = id & 7, v = (id >> 3) & 127, bh = id >> 10;
        float s[8];
#pragma unroll
        for (int i = 0; i < 8; ++i) s[i] = 0.f;
        for (int n0 = 0; n0 < 32; n0 += 8) {
            u32x4 kv[8]; f32x4 d0[8], d1[8];
#pragma unroll
            for (int j = 0; j < 8; ++j) { const int c = bh * 32 + n0 + j; kv[j] = *(const u32x4*)(ST + ((size_t)c * 128 + v) * 64 + dg * 8);
                d0[j] = *(const f32x4*)(dec + c * 64 + dg * 8); d1[j] = *(const f32x4*)(dec + c * 64 + dg * 8 + 4); }
#pragma unroll
            for (int j = 0; j < 8; ++j) { const int c = bh * 32 + n0 + j;
                u32x4 o; o.x = cvt_pk_bf16(s[0], s[1]); o.y = cvt_pk_bf16(s[2], s[3]); o.z = cvt_pk_bf16(s[4], s[5]); o.w = cvt_pk_bf16(s[6], s[7]);
                *(u32x4*)(ST + ((size_t)c * 128 + v) * 64 + dg * 8) = o;
                s[0] = d0[j][0] * s[0] + bflo(kv[j].x); s[1] = d0[j][1] * s[1] + bfhi(kv[j].x); s[2] = d0[j][2] * s[2] + bflo(kv[j].y); s[3] = d0[j][3] * s[3] + bfhi(kv[j].y);
                s[4] = d1[j][0] * s[4] + bflo(kv[j].z); s[5] = d1[j][1] * s[5] + bfhi(kv[j].z); s[6] = d1[j][2] * s[6] + bflo(kv[j].w); s[7] = d1[j][3] * s[7] + bfhi(kv[j].w); }
        }
    }
}
__device__ __forceinline__ void gla3_phase(const Args& a, unsigned char* ws, LAS unsigned char* lds, int l, int bid, int G) {
    const bf16_t* P = (const bf16_t*)(ws + WS_PROJ); const bf16_t* ST = (const bf16_t*)(ws + WS_S); bf16_t* Y = (bf16_t*)(ws + WS_Y);
    const float* AGG = (const float*)((const unsigned char*)a.out + DO_AGG); const float* PC = (const float*)((const unsigned char*)a.out + DO_PC); const float* AGGD = (const float*)((const unsigned char*)a.out + DO_AGGD);
    LAS float* Cs = (LAS float*)(lds + GL_CS);
    const float* onw = a.gla_onorm_w + l * 128;
    int tid_ = threadIdx.x; asm volatile("" : "+v"(tid_));
    const int tid = tid_, lane = tid & 63, w = __builtin_amdgcn_readfirstlane(tid >> 6), fr = lane & 15, fq = lane >> 4, seg = tid >> 6, d = tid & 63;
    LAS bf16_t* Ks = (LAS bf16_t*)(lds + GL_KE); LAS bf16_t* Vt = (LAS bf16_t*)(lds + GL_VT); LAS bf16_t* Qs = (LAS bf16_t*)(lds + GL_QS); LAS bf16_t* STs = (LAS bf16_t*)(lds + GL_ST);
    LAS float* tot = (LAS float*)(lds + GL_TOT); LAS float* red = (LAS float*)(lds + GL_RED);
    const int it = w >> 1, vh = w & 1;
    f32x4 onw4[4];
#pragma unroll
    for (int x = 0; x < 4; ++x) onw4[x] = *(const f32x4*)(onw + (vh * 4 + x) * 16 + fq * 4);
    GlaRegs R;
    if (bid < 256) gla_load<true>(R, P, ST, PC, bid * 8, seg, d, tid, w, fr, fq);
    for (int r = bid; r < 256; r += G) {
      {
        __syncthreads();
        const int q = r & 3, r0 = r & ~3, cv = tid >> 2, cd0 = (tid & 3) * 16;
        f32x4 C[4];
#pragma unroll
        for (int k = 0; k < 4; ++k) C[k] = (f32x4){0.f, 0.f, 0.f, 0.f};
        f32x4 Kk[3][4], Dd[3][4];
#pragma unroll
        for (int qq = 0; qq < 3; ++qq) { const int rr = r0 + (qq < q ? qq : 0);
#pragma unroll
            for (int k = 0; k < 4; ++k) { Kk[qq][k] = *(const f32x4*)(AGG + ((size_t)rr * 128 + cv) * 64 + cd0 + 4 * k); Dd[qq][k] = *(const f32x4*)(AGGD + rr * 64 + cd0 + 4 * k); } }
#pragma unroll
        for (int qq = 0; qq < 3; ++qq)
#pragma unroll
            for (int k = 0; k < 4; ++k) { const bool on = qq < q; C[k] = (on ? Dd[qq][k] : (f32x4){1.f, 1.f, 1.f, 1.f}) * C[k] + (on ? Kk[qq][k] : (f32x4){0.f, 0.f, 0.f, 0.f}); }
#pragma unroll
        for (int k = 0; k < 4; ++k) *(LAS f32x4*)(Cs + cv * 64 + cd0 + 4 * k) = C[k];
      }
      for (int ci = 0; ci < 8; ++ci) { const int c = r * 8 + ci;
        const int bh = c >> 5, n = c & 31, b = bh >> 2, h = bh & 3, row0 = b * SEQ + n * 64;
        __syncthreads();
        float bv[8], blast; gla_cumsum(R, tot, seg, d, bv, blast);
#pragma unroll
        for (int i = 0; i < 8; ++i) {
            const float qv = bf2f(R.q[i]) * 0.125f * __expf(bv[i]), kv = bf2f(R.k[i]) * __expf(-bv[i]);
            const unsigned pk = cvt_pk_bf16(qv, kv);
            Qs[(seg * 8 + i) * 72 + d] = (bf16_t)(pk & 0xffffu); Ks[(seg * 8 + i) * 72 + d] = (bf16_t)(pk >> 16); }
        gla_stage_v(R, Vt, seg, d);
#pragma unroll
        for (int j = 0; j < 2; ++j) { const int idx = j * 512 + tid, v = idx >> 3, c8 = idx & 7; const u32x4 st = R.st[j];
            const f32x4 c0 = *(const LAS f32x4*)(Cs + v * 64 + c8 * 8), c1 = *(const LAS f32x4*)(Cs + v * 64 + c8 * 8 + 4);
            u32x4 o; o.x = cvt_pk_bf16(bflo(st.x) + R.pc[0][0] * c0[0], bfhi(st.x) + R.pc[0][1] * c0[1]); o.y = cvt_pk_bf16(bflo(st.y) + R.pc[0][2] * c0[2], bfhi(st.y) + R.pc[0][3] * c0[3]);
            o.z = cvt_pk_bf16(bflo(st.z) + R.pc[1][0] * c1[0], bfhi(st.z) + R.pc[1][1] * c1[1]); o.w = cvt_pk_bf16(bflo(st.w) + R.pc[1][2] * c1[2], bfhi(st.w) + R.pc[1][3] * c1[3]);
            *(LAS u32x4*)(STs + v * 72 + c8 * 8) = o; }
        u32x2 rw[4];
#pragma unroll
        for (int x = 0; x < 4; ++x) rw[x] = R.r[x];
        { const int cn = (ci < 7) ? c + 1 : (r + G) * 8; if (cn < 2048) gla_load<true>(R, P, ST, PC, cn, seg, d, tid, w, fr, fq); }
        __syncthreads();
        bf16x8 bq[2];
#pragma unroll
        for (int ks = 0; ks < 2; ++ks) bq[ks] = *(const LAS bf16x8*)(Qs + (it * 16 + fr) * 72 + ks * 32 + fq * 8);
        f32x4 at[4];
#pragma unroll
        for (int jt = 0; jt < 4; ++jt) { at[jt] = (f32x4){0.f, 0.f, 0.f, 0.f};
#pragma unroll
            for (int ks = 0; ks < 2; ++ks) { const bf16x8 ka = *(const LAS bf16x8*)(Ks + (jt * 16 + fr) * 72 + ks * 32 + fq * 8);
                at[jt] = __builtin_amdgcn_mfma_f32_16x16x32_bf16(ka, bq[ks], at[jt], 0, 0, 0); }
#pragma unroll
            for (int jj = 0; jj < 4; ++jj) { const int j = jt * 16 + fq * 4 + jj, i = it * 16 + fr; at[jt][jj] = (j <= i) ? at[jt][jj] : 0.f; } }
        union { u32x4 u; bf16x8 h; } bp[2];
#pragma unroll
        for (int kp = 0; kp < 2; ++kp) { bp[kp].u.x = cvt_pk_bf16(at[2 * kp][0], at[2 * kp][1]); bp[kp].u.y = cvt_pk_bf16(at[2 * kp][2], at[2 * kp][3]);
            bp[kp].u.z = cvt_pk_bf16(at[2 * kp + 1][0], at[2 * kp + 1][1]); bp[kp].u.w = cvt_pk_bf16(at[2 * kp + 1][2], at[2 * kp + 1][3]); }
        f32x4 o[4]; float ssq = 0.f;
#pragma unroll
        for (int x = 0; x < 4; ++x) { const int vt = vh * 4 + x; o[x] = (f32x4){0.f, 0.f, 0.f, 0.f};
#pragma unroll
            for (int kp = 0; kp < 2; ++kp) { union { u32x4 u; bf16x8 h; } va;
                const u32x2 lo = *(const LAS u32x2*)(Vt + (vt * 16 + fr) * 72 + (2 * kp) * 16 + fq * 4), hi = *(const LAS u32x2*)(Vt + (vt * 16 + fr) * 72 + (2 * kp + 1) * 16 + fq * 4);
                va.u.x = lo.x; va.u.y = lo.y; va.u.z = hi.x; va.u.w = hi.y;
                o[x] = __builtin_amdgcn_mfma_f32_16x16x32_bf16(va.h, bp[kp].h, o[x], 0, 0, 0); }
#pragma unroll
            for (int ks = 0; ks < 2; ++ks) { const bf16x8 sa = *(const LAS bf16x8*)(STs + (vt * 16 + fr) * 72 + ks * 32 + fq * 8);
                o[x] = __builtin_amdgcn_mfma_f32_16x16x32_bf16(sa, bq[ks], o[x], 0, 0, 0); }
            ssq += (o[x][0] * o[x][0] + o[x][1] * o[x][1]) + (o[x][2] * o[x][2] + o[x][3] * o[x][3]); }
        ssq += __shfl_xor(ssq, 16); ssq += __shfl_xor(ssq, 32);
        if (fq == 0) red[(it * 16 + fr) * 2 + vh] = ssq;
        __syncthreads();
        const float rstd = rsqrtf((red[(it * 16 + fr) * 2] + red[(it * 16 + fr) * 2 + 1]) * (1.0f / 128.0f) + EPS);
        const int row = row0 + it * 16 + fr;
#pragma unroll
        for (int x = 0; x < 4; ++x) { const int vcol = (vh * 4 + x) * 16 + fq * 4;
            const f32x4 ow = onw4[x];
            const float r0 = bflo(rw[x].x), r1 = bfhi(rw[x].x), r2 = bflo(rw[x].y), r3 = bfhi(rw[x].y);
            const float y0 = o[x][0] * rstd * ow[0] * r0 * fsigmoid(r0), y1 = o[x][1] * rstd * ow[1] * r1 * fsigmoid(r1);
            const float y2 = o[x][2] * rstd * ow[2] * r2 * fsigmoid(r2), y3 = o[x][3] * rstd * ow[3] * r3 * fsigmoid(r3);
            u32x2 ov; ov.x = cvt_pk_bf16(y0, y1); ov.y = cvt_pk_bf16(y2, y3);
            *(u32x2*)(Y + (size_t)row * YW + 512 + h * 128 + vcol) = ov; }
      }
    }
    __syncthreads();
}

#define RLX_AGENT __ATOMIC_RELAXED, __HIP_MEMORY_SCOPE_AGENT
constexpr size_t WS_BAR = 3 * MiB;
constexpr int MISC_OFF = 131072 + 320;
#define XB_TMO      128
#define XB_XCNT(j)  (256  + 64 * (j))
#define XB_XSUB(j)  (1280 + 64 * (j))
#define XB_XGEN(j)  (2304 + 64 * (j))
#define XB_TOP      3328
#define XB_TOPGEN   3392
#define XCD_BAR_WORDS 3456
#define XB_SPIN_CAP (1u << 18)

__device__ __forceinline__ unsigned xb_ld(unsigned* p)              { return __hip_atomic_load(p, __ATOMIC_RELAXED, __HIP_MEMORY_SCOPE_AGENT); }
__device__ __forceinline__ unsigned xb_add(unsigned* p, unsigned v) { return __hip_atomic_fetch_add(p, v, __ATOMIC_RELAXED, __HIP_MEMORY_SCOPE_AGENT); }
__device__ __forceinline__ unsigned xb_xcc_id() { return (unsigned)__builtin_amdgcn_s_getreg((3 << 11) | 20) & 0xFu; }
#define XB_SPIN(cond, bar) do { unsigned _sp = 0; while (cond) { __builtin_amdgcn_s_sleep(1); \
    if ((++_sp & 255u) == 0u) { if (xb_ld(&(bar)[XB_TMO])) break; if (_sp > XB_SPIN_CAP) { atomicAdd(&(bar)[XB_TMO], 1u); break; } } } } while (0)

struct XcdBarrier {
    unsigned* bar; unsigned x;
    volatile LAS unsigned* st;
};

__device__ __forceinline__ XcdBarrier xcd_barrier_post(unsigned* bar, volatile LAS unsigned* st) {
    XcdBarrier b; b.bar = bar; b.x = xb_xcc_id(); b.st = st;
    if (threadIdx.x == 0) (void)xb_add(&bar[XB_XCNT(b.x)], 1u);
    return b;
}
__device__ __forceinline__ void xcd_barrier_complete(unsigned* bar, unsigned x, unsigned& nloc, unsigned& nx) {
    const unsigned G = gridDim.x * gridDim.y * gridDim.z;
    unsigned sum, cnt, mine, sp = 0u;
    for (;;) {
        sum = 0u; cnt = 0u; mine = 0u;
#pragma unroll
        for (unsigned j = 0; j < 16; ++j) { const unsigned c = xb_ld(&bar[XB_XCNT(j)]); sum += c; cnt += (c > 0u) ? 1u : 0u; mine = (j == x) ? c : mine; }
        if (sum == G) break;
        __builtin_amdgcn_s_sleep(1);
        if ((++sp & 255u) == 0u) { if (xb_ld(&bar[XB_TMO])) break; if (sp > XB_SPIN_CAP) { atomicAdd(&bar[XB_TMO], 1u); break; } }
    }
    nloc = mine > 0u ? mine : 1u; nx = cnt > 0u ? cnt : 1u;
}

__device__ __forceinline__ void xcd_barrier(const XcdBarrier& b) {
    asm volatile("s_waitcnt vmcnt(0)" ::: "memory");
    __syncthreads();
    if (threadIdx.x == 0) {
        unsigned* bar = b.bar;
        __builtin_amdgcn_s_waitcnt(0);
        unsigned nloc = b.st[0], nx = b.st[1];
        if (nloc == 0u) { xcd_barrier_complete(bar, b.x, nloc, nx); b.st[0] = nloc; b.st[1] = nx; }
        const unsigned old = xb_add(&bar[XB_XSUB(b.x)], 1u);
        const unsigned gen = old / nloc;
        if (old + 1u == (gen + 1u) * nloc) {
            __builtin_amdgcn_fence(__ATOMIC_RELEASE, "agent");
            asm volatile("s_waitcnt vmcnt(0)" ::: "memory");
            const unsigned og = xb_add(&bar[XB_TOP], 1u);
            const unsigned tg = og / nx;
            if (og + 1u == (tg + 1u) * nx) xb_add(&bar[XB_TOPGEN], 1u);
            else XB_SPIN(xb_ld(&bar[XB_TOPGEN]) == tg, bar);
            __builtin_amdgcn_fence(__ATOMIC_ACQUIRE, "agent");
            xb_add(&bar[XB_XGEN(b.x)], 1u);
            asm volatile("s_waitcnt vmcnt(0)" ::: "memory");
        } else {
            XB_SPIN(xb_ld(&bar[XB_XGEN(b.x)]) == gen, bar);
            __builtin_amdgcn_fence(__ATOMIC_ACQUIRE, "agent");
            asm volatile("s_waitcnt vmcnt(0)" ::: "memory");
        }
    }
    __syncthreads();
}


typedef const __attribute__((address_space(4))) Args* ArgsPtr;
#define CG_SYNC() do { asm volatile("s_waitcnt vmcnt(0) lgkmcnt(0)" ::: "memory"); grid.sync(); __builtin_amdgcn_fence(__ATOMIC_ACQUIRE, "agent"); asm volatile("s_waitcnt vmcnt(0)" ::: "memory"); } while (0)
#define GRID_SYNC() do { ArgsPtr ap_ = (ArgsPtr)__builtin_amdgcn_kernarg_segment_ptr(); asm volatile("" : "+s"(ap_)); XcdBarrier xb_; xb_.bar = (unsigned*)(ap_->ws + WS_BAR); xb_.x = xb_xcc_id(); \
    xb_.st = (volatile LAS unsigned*)(lds + MISC_OFF) + 8; xcd_barrier(xb_); } while (0)
#define PH_BEGIN ArgsPtr ap = (ArgsPtr)__builtin_amdgcn_kernarg_segment_ptr(); int bid = blockIdx.x, G = gridDim.x; asm volatile("" : "+s"(ap), "+s"(bid), "+s"(G)); \
    const Args a = *ap; unsigned char* ws = a.ws; int tid = threadIdx.x; asm volatile("" : "+v"(tid)); const int lane = tid & 63, wave = __builtin_amdgcn_readfirstlane(tid >> 6); \
    const int gw = bid * 8 + wave, NGW = G * 8, gtid = bid * 512 + tid, gsz = G * 512; LAS float* scr = (LAS float*)(lds + wave * 16384); \
    (void)lane; (void)gw; (void)NGW; (void)gtid; (void)gsz; (void)scr; (void)ws;
__global__ void __launch_bounds__(512, 2) fwd_megakernel(Args a_unused) {
#if defined(__HIP_DEVICE_COMPILE__)
    extern __shared__ __attribute__((aligned(16))) unsigned char lds_raw[];
    cg::grid_group grid = cg::this_grid();
    LAS unsigned char* lds = (LAS unsigned char*)lds_raw;
    for (int u = threadIdx.x; u < (LDS_BYTES - 131072) / 4; u += 512) ((LAS unsigned*)(lds + 131072))[u] = 0u;
    __syncthreads();
    { ArgsPtr ap_ = (ArgsPtr)__builtin_amdgcn_kernarg_segment_ptr();
      if (blockIdx.x == 0) { unsigned* bw = (unsigned*)(ap_->ws + WS_BAR); for (int u = threadIdx.x; u < XCD_BAR_WORDS; u += 512) bw[u] = 0u; } }

    { PH_BEGIN
      for (int wl = 0; wl < 2; ++wl) { conv_w_in_main(a, ws, scr, wl, gw, NGW, lane); conv_w_gate(a, ws, scr, wl, gw, NGW, lane); conv_w_br(a, ws, scr, wl, gw, NGW, lane);
        conv_w_o(a, ws, scr, wl, gw, NGW, lane); conv_w_up(a, ws, scr, wl, gw, NGW, lane); conv_w_dn(a, ws, scr, wl, gw, NGW, lane); }
      bf16_t* XB = (bf16_t*)(ws + WS_XB); float* ssA = (float*)(ws + WS_SSA); float* ssB = (float*)(ws + WS_SSB);
      for (int m = gw; m < M; m += NGW) {
        const f32x4* xr = (const f32x4*)(a.x + (size_t)m * D) + lane; f32x4 v[4]; float s = 0.f;
#pragma unroll
        for (int j = 0; j < 4; ++j) { v[j] = xr[64 * j]; s += (v[j][0] * v[j][0] + v[j][1] * v[j][1]) + (v[j][2] * v[j][2] + v[j][3] * v[j][3]); }
        s = wave_sum(s);
        u32x2* o8 = (u32x2*)(XB + (size_t)m * D) + lane;
#pragma unroll
        for (int j = 0; j < 4; ++j) { u32x2 o; o.x = cvt_pk_bf16(v[j][0], v[j][1]); o.y = cvt_pk_bf16(v[j][2], v[j][3]); o8[64 * j] = o; }
        { unsigned* o4 = (unsigned*)((unsigned char*)a.out + (size_t)m * D) + lane;
#pragma unroll
          for (int j = 0; j < 4; ++j) o4[64 * j] = pk4_fp8(v[j][0], v[j][1], v[j][2], v[j][3]); }
        if (lane == 0) { ssA[m] = s; ssB[m] = 0.f; }
      }
    }
    CG_SYNC();
    { ArgsPtr ap_ = (ArgsPtr)__builtin_amdgcn_kernarg_segment_ptr(); (void)xcd_barrier_post((unsigned*)(ap_->ws + WS_BAR), (volatile LAS unsigned*)(lds + MISC_OFF) + 8); }

#pragma nounroll
    for (int l = 0; l < 2; ++l) {
        { PH_BEGIN
          pg8::Gemm g{(const bf16_t*)(ws + WS_XB), (const bf16_t*)wptr(a, ws, l, WS_WIN), D, D, D}; pg8::StaticOrder S; S.init(M, NPROJ, G, bid);
          pg8::EpiProj E{(bf16_t*)(ws + WS_PROJ), (const float*)(ws + WS_SSA), a.gla_ba + l * 256};
          pg8::gemm_phase<pg8::EpiProj, pg8::StaticOrder>(lds, g, S, E); }
        GRID_SYNC();
        { PH_BEGIN
          conv_phase(a, ws, l, gtid, gsz); }
        { PH_BEGIN
          swa_phase(a, ws, lds, l, bid, G); }
        { PH_BEGIN
          gla1_phase(a, ws, lds, bid, G); }
        GRID_SYNC();
        { PH_BEGIN
          gla3_phase(a, ws, lds, l, bid, G); }
        GRID_SYNC();
        { PH_BEGIN
          pg8::Gemm g{(const bf16_t*)a.out, (const bf16_t*)wptr(a, ws, l, WS_WG), D / 2, D / 2, D / 2}; pg8::GateOrder S; S.init(M, G, bid);
          pg8::EpiGate E{(bf16_t*)(ws + WS_PROJ), (const float*)(ws + WS_SSA), 1.0f / WG8_SCALE};
          pg8::gemm_phase<pg8::EpiGate, pg8::GateOrder, true>(lds, g, S, E); }
        { PH_BEGIN
          pg8::Gemm g{(const bf16_t*)(ws + WS_Y), (const bf16_t*)wptr(a, ws, l, WS_WBR), YW, 512, 512}; pg8::BrOrder S; S.init(M, G, bid);
          pg8::EpiBr E{(const bf16_t*)(ws + WS_PROJ), (bf16_t*)(ws + WS_MIXED)};
          pg8::gemm_phase<pg8::EpiBr, pg8::BrOrder>(lds, g, S, E); }
        GRID_SYNC();
        { PH_BEGIN
          { float* z = (float*)(ws + WS_SSA); for (int i = gtid; i < M; i += gsz) z[i] = 0.f; }
          pg8::Gemm g{(const bf16_t*)(ws + WS_MIXED), (const bf16_t*)wptr(a, ws, l, WS_WO), D, D, D}; pg8::StaticOrder S; S.init(M, D, G, bid);
          pg8::EpiRes E{(float*)nullptr, (bf16_t*)(ws + WS_XB), (float*)(ws + WS_SSB), (unsigned char*)nullptr};
          pg8::gemm_phase<pg8::EpiRes, pg8::StaticOrder>(lds, g, S, E); }
        GRID_SYNC();
        { PH_BEGIN
          pg8::Gemm g{(const bf16_t*)(ws + WS_XB), (const bf16_t*)wptr(a, ws, l, WS_WUP), D, D, D}; pg8::StaticOrder S; S.init(M, DFF, G, bid);
          pg8::EpiUp E{(bf16_t*)(ws + WS_PROJ), (const float*)(ws + WS_SSB)};
          pg8::gemm_phase<pg8::EpiUp, pg8::StaticOrder>(lds, g, S, E); }
        GRID_SYNC();
        { PH_BEGIN
          { float* z = (float*)(ws + WS_SSB); for (int i = gtid; i < M; i += gsz) z[i] = 0.f; }
          pg8::Gemm g{(const bf16_t*)(ws + WS_PROJ), (const bf16_t*)wdn_ptr(ws, l), DFF, DFF, DFF}; pg8::StaticOrder S; S.init(M, D, G, bid);
          pg8::EpiRes E{l == 1 ? a.out : (float*)nullptr, (bf16_t*)(ws + WS_XB), (float*)(ws + WS_SSA), l == 0 ? (unsigned char*)a.out : (unsigned char*)nullptr};
          pg8::gemm_phase<pg8::EpiRes, pg8::StaticOrder>(lds, g, S, E); }
        if (l == 0) GRID_SYNC();
    }
#endif
}

extern "C" void kernel_launch(void* const* d_in, const int* in_sizes, int n_in, void* d_out, int out_size, void* d_ws, size_t ws_size, hipStream_t stream) {
    static int grid = 0;
    if (grid == 0) {
        int dev = 0, cus = 0, per_cu = 0;
        if (hipGetDevice(&dev) != hipSuccess || hipDeviceGetAttribute(&cus, hipDeviceAttributeMultiprocessorCount, dev) != hipSuccess) { grid = -1; return; }
        if (hipFuncSetAttribute((const void*)fwd_megakernel, hipFuncAttributeMaxDynamicSharedMemorySize, LDS_BYTES) != hipSuccess) { fprintf(stderr, "hipFuncSetAttribute failed\n"); grid = -1; return; }
        if (hipOccupancyMaxActiveBlocksPerMultiprocessor(&per_cu, (const void*)fwd_megakernel, 512, LDS_BYTES) != hipSuccess || per_cu < 1) { fprintf(stderr, "occupancy query: %d\n", per_cu); per_cu = 1; }
        (void)hipGetLastError();
        if (per_cu > 1) per_cu = 1;
        grid = cus * per_cu;
        if (ws_size < WS_END) { fprintf(stderr, "workspace too small: %zu < %zu\n", ws_size, (size_t)WS_END); grid = -1; return; }
    }
    if (grid < 0) return;
    Args a{};
    a.x = (const float*)d_in[0]; a.pos = (const int*)d_in[1]; a.norm1_w = (const float*)d_in[2]; a.w_in = (const float*)d_in[3]; a.conv_w = (const float*)d_in[4]; a.conv_b = (const float*)d_in[5];
    a.gla_wa2 = (const float*)d_in[6]; a.gla_ba = (const float*)d_in[7]; a.gla_onorm_w = (const float*)d_in[8]; a.q_norm_w = (const float*)d_in[9]; a.k_norm_w = (const float*)d_in[10]; a.sinks = (const float*)d_in[11];
    a.w_branch = (const float*)d_in[12]; a.w_o = (const float*)d_in[13]; a.norm2_w = (const float*)d_in[14]; a.w_up = (const float*)d_in[15]; a.w_down = (const float*)d_in[16];
    a.out = (float*)d_out; a.ws = (unsigned char*)d_ws;
    void* args[] = {&a};
    hipError_t e = hipLaunchCooperativeKernel((const void*)fwd_megakernel, dim3(grid), dim3(512), args, LDS_BYTES, stream);
    if (e != hipSuccess) fprintf(stderr, "cooperative launch failed: %s (grid %d)\n", hipGetErrorString(e), grid);
}
```
